# Optimizing an MI355X kernel written in HIP

```python
import math
import jax, jax.numpy as jnp
from jax import lax
import numpy as np

D_MODEL = 1024
BATCH = 32
SEQ = 2048
DEPTH = 1

HEAD_DIM = 64
ATTN_HEADS_PER_GROUP = 8
DILATED_GROUPS = ((128, 1), (512, 4), (2048, 16))
N_GROUPS = 3
ATTN_WIDTH = ATTN_HEADS_PER_GROUP * HEAD_DIM
N_ATTN_HEADS = N_GROUPS * ATTN_HEADS_PER_GROUP
QBLOCK = 128
N_BUCKETS = 32
MAX_DISTANCE = 2048
RWKV_HEADS = 8
RWKV_HEAD_SIZE = 64
RWKV_WIDTH = RWKV_HEADS * RWKV_HEAD_SIZE
DECAY_LORA = 64
AAA_LORA = 64
GN_EPS = 64e-5
RMS_EPS = 1e-6

QKV_COLS = 3 * N_GROUPS * ATTN_WIDTH
OFF_ATTN_GATE = QKV_COLS
OFF_RWKV = OFF_ATTN_GATE + ATTN_WIDTH
RWKV_SHIFT_COLS = 3 * RWKV_WIDTH + DECAY_LORA + AAA_LORA
OFF_RWKV_GATE = OFF_RWKV + RWKV_SHIFT_COLS
OFF_MERGE = OFF_RWKV_GATE + RWKV_WIDTH
IN_COLS = OFF_MERGE + 2 * D_MODEL

kernel_name = "hybrid_dilated_attn_rwkv7_gated_merge"


def rms_norm(x, g):
    xf = x.astype(jnp.float32)
    y = xf * lax.rsqrt(jnp.mean(xf * xf, axis=-1, keepdims=True) + RMS_EPS) * g.astype(jnp.float32)
    return y.astype(x.dtype)


def t5_causal_bucket(dist):
    d = np.maximum(np.asarray(dist), 0)
    max_exact = N_BUCKETS // 2
    ratio = np.log(np.maximum(d, 1).astype(np.float32) / max_exact) / np.float32(math.log(MAX_DISTANCE / max_exact))
    large = max_exact + (ratio * (N_BUCKETS - max_exact)).astype(np.int32)
    large = np.minimum(large, N_BUCKETS - 1)
    return np.where(d < max_exact, d, large).astype(np.int32)


def dilated_group_attention(q, k, v, bias_table_g, window, dilation):
    B, S, H, Dh = q.shape
    L = S // dilation
    steps = window // dilation
    nb = -(-L // QBLOCK)
    Lp = nb * QBLOCK

    def to_blocks(t):
        t = t.reshape(B, L, dilation, H, Dh).transpose(0, 2, 3, 1, 4)
        t = jnp.pad(t, ((0, 0), (0, 0), (0, 0), (0, Lp - L), (0, 0)))
        return t.reshape(B, dilation, H, nb, QBLOCK, Dh)

    def with_prev(t):
        prev = jnp.pad(t, ((0, 0), (0, 0), (0, 0), (1, 0), (0, 0), (0, 0)))[:, :, :, :-1]
        return jnp.concatenate([prev, t], axis=4)

    qb = to_blocks(q)
    kb = with_prev(to_blocks(k))
    vb = with_prev(to_blocks(v))

    qi = np.arange(QBLOCK)[:, None] + QBLOCK
    ki = np.arange(2 * QBLOCK)[None, :]
    rel = qi - ki
    band = (rel >= 0) & (rel <= steps)
    has_prev = (np.arange(nb)[:, None, None] > 0) | (ki >= QBLOCK)[None]
    valid = band[None] & has_prev
    bucket = t5_causal_bucket(np.maximum(rel, 0) * dilation)
    bias = bias_table_g.astype(jnp.float32)[bucket].transpose(2, 0, 1)

    scale = 1.0 / math.sqrt(Dh)
    logits = jnp.einsum('bdhnqc,bdhnkc->bdhnqk', qb, kb) * scale + bias[None, None, :, None]
    logits = jnp.where(valid, logits, -jnp.inf)
    m = jnp.max(logits, axis=-1)
    p = jnp.exp(logits - m[..., None])
    s = jnp.sum(p, axis=-1)
    num = jnp.einsum('bdhnqk,bdhnkc->bdhnqc', p, vb)

    def unblock(t):
        C = t.shape[-1]
        t = t.reshape(B, dilation, H, Lp, C)[:, :, :, :L]
        return t.transpose(0, 3, 1, 2, 4).reshape(B, S, H, C)

    return unblock(num), unblock(s[..., None])[..., 0], unblock(m[..., None])[..., 0]


def rwkv7_scan(r, decay, k, v, a_in, b_in):
    B, S, H, N = r.shape
    xs = tuple(t.transpose(1, 0, 2, 3) for t in (r, decay, k, v, a_in, b_in))

    def step(state, inp):
        r_t, w_t, k_t, v_t, a_t, b_t = inp
        sa = jnp.einsum('bhvk,bhk->bhv', state, a_t)
        state = (state * w_t[:, :, None, :] + sa[..., None] * b_t[:, :, None, :]
                 + v_t[..., None] * k_t[:, :, None, :])
        y = jnp.einsum('bhvk,bhk->bhv', state, r_t)
        return state, y

    s0 = jnp.zeros((B, H, N, N), jnp.float32)
    _, ys = lax.scan(step, s0, xs)
    return ys.transpose(1, 0, 2, 3)


def setup_inputs(seed: int = 0) -> dict:
    key = jax.random.key(seed)
    ks = jax.random.split(key, 20)
    f32 = jnp.float32
    nrm = lambda k, shape: jax.random.normal(k, shape, f32)
    L = DEPTH
    return {
        "x": nrm(ks[0], (BATCH, SEQ, D_MODEL)),
        "pre_norm_gain": 1.0 + 0.05 * nrm(ks[1], (L, D_MODEL)),
        "w_in": nrm(ks[2], (L, D_MODEL, IN_COLS)) * D_MODEL ** -0.5,
        "rel_bias": 0.5 * nrm(ks[3], (N_BUCKETS, N_ATTN_HEADS)),
        "rwkv_shift_mix": jax.random.uniform(ks[4], (L, RWKV_SHIFT_COLS), f32),
        "rwkv_w0": jax.random.uniform(ks[5], (L, RWKV_WIDTH), f32, -6.0, 1.0),
        "rwkv_w_up": nrm(ks[6], (L, DECAY_LORA, RWKV_WIDTH)) * 0.5 * DECAY_LORA ** -0.5,
        "rwkv_a0": 0.5 * nrm(ks[7], (L, RWKV_WIDTH)),
        "rwkv_a_up": nrm(ks[8], (L, AAA_LORA, RWKV_WIDTH)) * 0.5 * AAA_LORA ** -0.5,
        "rwkv_k_k": 0.85 + 0.05 * nrm(ks[9], (L, RWKV_WIDTH)),
        "rwkv_k_a": 1.0 + 0.05 * nrm(ks[10], (L, RWKV_WIDTH)),
        "rwkv_r_k": 0.1 * nrm(ks[11], (L, RWKV_HEADS, RWKV_HEAD_SIZE)),
        "rwkv_ln_w": 1.0 + 0.05 * nrm(ks[12], (L, RWKV_WIDTH)),
        "rwkv_ln_b": 0.01 * nrm(ks[13], (L, RWKV_WIDTH)),
        "w_up_attn": nrm(ks[14], (L, ATTN_WIDTH, D_MODEL)) * ATTN_WIDTH ** -0.5,
        "w_up_rwkv": nrm(ks[15], (L, RWKV_WIDTH, D_MODEL)) * RWKV_WIDTH ** -0.5,
        "w_out": nrm(ks[16], (L, D_MODEL, D_MODEL)) * D_MODEL ** -0.5,
        "post_norm_gain": 1.0 + 0.05 * nrm(ks[17], (L, D_MODEL)),
    }


def reference(x, pre_norm_gain, w_in, rel_bias, rwkv_shift_mix, rwkv_w0, rwkv_w_up,
              rwkv_a0, rwkv_a_up, rwkv_k_k, rwkv_k_a, rwkv_r_k, rwkv_ln_w, rwkv_ln_b,
              w_up_attn, w_up_rwkv, w_out, post_norm_gain):
    B, S, D = x.shape
    f32 = jnp.float32
    for l in range(DEPTH):
        h = rms_norm(x, pre_norm_gain[l])
        proj = h @ w_in[l]

        qkv = proj[..., :QKV_COLS].astype(f32).reshape(
            B, S, 3, N_GROUPS, ATTN_HEADS_PER_GROUP, HEAD_DIM)
        nums, dens, maxes = [], [], []
        for g, (window, dilation) in enumerate(DILATED_GROUPS):
            table_g = rel_bias[:, g * ATTN_HEADS_PER_GROUP:(g + 1) * ATTN_HEADS_PER_GROUP]
            num, den, mx = dilated_group_attention(
                qkv[:, :, 0, g], qkv[:, :, 1, g], qkv[:, :, 2, g], table_g, window, dilation)
            nums.append(num); dens.append(den); maxes.append(mx)
        m_all = jnp.max(jnp.stack(maxes), axis=0)
        wts = [jnp.exp(mx - m_all) for mx in maxes]
        num_tot = sum(w[..., None] * n for w, n in zip(wts, nums))
        den_tot = sum(w * d for w, d in zip(wts, dens))
        o_attn = (num_tot / den_tot[..., None]).reshape(B, S, ATTN_WIDTH).astype(x.dtype)
        z_attn = proj[..., OFF_ATTN_GATE:OFF_RWKV]
        y_attn = (o_attn * jax.nn.silu(z_attn)) @ w_up_attn[l]

        pr = proj[..., OFF_RWKV:OFF_RWKV_GATE].astype(f32)
        pr_prev = jnp.pad(pr, ((0, 0), (1, 0), (0, 0)))[:, :-1]
        pr = pr + (pr_prev - pr) * rwkv_shift_mix[l].astype(f32)
        r = pr[..., :RWKV_WIDTH]
        k = pr[..., RWKV_WIDTH:2 * RWKV_WIDTH]
        v = pr[..., 2 * RWKV_WIDTH:3 * RWKV_WIDTH]
        w_low = pr[..., 3 * RWKV_WIDTH:3 * RWKV_WIDTH + DECAY_LORA]
        a_low = pr[..., 3 * RWKV_WIDTH + DECAY_LORA:]
        w_log = -jax.nn.softplus(-(rwkv_w0[l].astype(f32) + jnp.tanh(w_low) @ rwkv_w_up[l].astype(f32))) - 0.5
        decay = jnp.exp(-jnp.exp(w_log))
        a = jax.nn.sigmoid(rwkv_a0[l].astype(f32) + a_low @ rwkv_a_up[l].astype(f32))
        hs = (B, S, RWKV_HEADS, RWKV_HEAD_SIZE)
        kk = (k * rwkv_k_k[l].astype(f32)).reshape(hs)
        kk = kk / jnp.maximum(jnp.linalg.norm(kk, axis=-1, keepdims=True), 1e-12)
        k = k * (1.0 + (a - 1.0) * rwkv_k_a[l].astype(f32))
        r4, k4, v4 = r.reshape(hs), k.reshape(hs), v.reshape(hs)
        y = rwkv7_scan(r4, decay.reshape(hs), k4, v4, -kk, kk * a.reshape(hs))
        mu = jnp.mean(y, axis=-1, keepdims=True)
        var = jnp.mean(jnp.square(y - mu), axis=-1, keepdims=True)
        y = ((y - mu) * lax.rsqrt(var + GN_EPS)).reshape(B, S, RWKV_WIDTH)
        y = y * rwkv_ln_w[l].astype(f32) + rwkv_ln_b[l].astype(f32)
        bonus = jnp.sum(r4 * k4 * rwkv_r_k[l].astype(f32), axis=-1, keepdims=True) * v4
        o_rwkv = (y + bonus.reshape(B, S, RWKV_WIDTH)).astype(x.dtype)
        z_rwkv = proj[..., OFF_RWKV_GATE:OFF_MERGE]
        y_rwkv = (o_rwkv * jax.nn.silu(z_rwkv)) @ w_up_rwkv[l]

        g_attn = proj[..., OFF_MERGE:OFF_MERGE + D_MODEL]
        g_rwkv = proj[..., OFF_MERGE + D_MODEL:]
        merged = jax.nn.sigmoid(g_attn) * y_attn + jax.nn.sigmoid(g_rwkv) * y_rwkv
        out = merged @ w_out[l]
        x = x + rms_norm(out, post_norm_gain[l])
    return x
```

```cpp
#include <hip/hip_runtime.h>
#include <cstdio>
#include <cstdint>
namespace pg8 {
#define PG8_LAS __attribute__((address_space(3)))
typedef unsigned short bf16_t;
typedef short bf16x8 __attribute__((ext_vector_type(8)));
typedef float f32x4 __attribute__((ext_vector_type(4)));
typedef unsigned u32x4 __attribute__((ext_vector_type(4)));
constexpr int BM = 256, BK = 64, HALF = 128, HTB = HALF * BK * 2  , STAGE_BYTES = 8 * HTB, NXCD = 8, WGM = 8;

__host__ __device__ __forceinline__ int lds_byte(int r, int c) { const int st = (r >> 4) * 2 + (c >> 5), rr = r & 15, cc = c & 31, ob = rr * 64 + cc * 2; return st * 1024 + (ob ^ (((ob >> 9) & 1) << 5)); }
__host__ __device__ __forceinline__ void stage_rc(int b, int& R, int& C) { const int st = b / 1024, sb = b % 1024, swz = sb ^ (((sb >> 9) & 1) << 5); R = (st >> 1) * 16 + swz / 64; C = (st & 1) * 32 + (swz % 64) / 2; }
__host__ __device__ __forceinline__ int perm32(int rho) { const int n = rho >> 4, i = rho & 15; return 8 * (i >> 2) + 4 * n + (i & 3); }

struct Unit { int pm, pn; };
struct Gemm { const bf16_t* A; const bf16_t* Bt; int M, N, K; };

struct StaticOrder {
    int nM, nN, nwg, G, c;
    __host__ __device__ void init(int M, int N, int G_, int c_) { nM = M / BM; nN = N / BM; nwg = nM * nN; G = G_; c = c_; }
    __host__ __device__ bool next(int i, Unit& u) const {
        const long L = (long)i * G + c; if (L >= nwg) return false;
        int wgid = (int)L; { const int q = nwg / NXCD, r = nwg % NXCD, xcd = wgid % NXCD, off = wgid / NXCD; wgid = (xcd < r ? xcd * (q + 1) : r * (q + 1) + (xcd - r) * q) + off; }
        const int nig = WGM * nN, gid = wgid / nig, fm = gid * WGM, gsz = (nM - fm) < WGM ? (nM - fm) : WGM;
        u.pm = fm + ((wgid % nig) % gsz); u.pn = (wgid % nig) / gsz; return true;
    }
    __device__ __forceinline__ void a_ready(const Unit&) const {}
    __device__ __forceinline__ void done(const Unit&) const {}
};

__device__ __forceinline__ unsigned cvt_pk_bf16(float lo, float hi) { unsigned r; asm volatile("v_cvt_pk_bf16_f32 %0, %1, %2" : "=v"(r) : "v"(lo), "v"(hi)); return r; }
typedef unsigned u32x4 __attribute__((ext_vector_type(4)));
typedef unsigned u32x2 __attribute__((ext_vector_type(2)));
__device__ __forceinline__ float bf_lo(unsigned w) { return __builtin_bit_cast(float, w << 16); }
__device__ __forceinline__ float bf_hi(unsigned w) { return __builtin_bit_cast(float, w & 0xffff0000u); }
__device__ __forceinline__ float sigmoid_f(float z) { return __builtin_amdgcn_rcpf(1.0f + __builtin_amdgcn_exp2f(-1.4426950408889634f * z)); }
constexpr float QSCALE = 0.125f * 1.4426950408889634f;

struct PanelOrder {
    int pm, nN;
    __device__ __forceinline__ bool next(int i, Unit& u) const { if (i >= nN) return false; u.pm = pm; u.pn = i; return true; }
    __device__ __forceinline__ void a_ready(const Unit&) const {}
    __device__ __forceinline__ void done(const Unit&) const {}
};

struct Epi1 {
    static constexpr bool PERM = true, AFTER_DRAIN = false;
    bf16_t* QKV; bf16_t* RW;
    __device__ __forceinline__ void operator()(const f32x4 (&acc)[2][2][4][2], const Unit& u, int wr, int wc, int fr, int fq) const {
        const int row0 = u.pm * BM + wr * 64 + fr;
        bf16_t* base; int ldc, colt; float sc = 1.f;
        if (u.pn < 18) { base = QKV; ldc = 4608; colt = u.pn * BM; if (u.pn < 6) sc = QSCALE; } else { base = RW; ldc = 1792; colt = (u.pn - 18) * BM; }
        const int col0 = colt + wc * 32 + 8 * fq;
#pragma unroll
        for (int ai = 0; ai < 2; ++ai)
#pragma unroll
            for (int m = 0; m < 4; ++m) { bf16_t* rowp = base + (size_t)(row0 + ai * HALF + m * 16) * ldc + col0;
#pragma unroll
                for (int bj = 0; bj < 2; ++bj) { const f32x4 v0 = acc[ai][bj][m][0] * sc, v1 = acc[ai][bj][m][1] * sc;
                    u32x4 w; w.x = cvt_pk_bf16(v0[0], v0[1]); w.y = cvt_pk_bf16(v0[2], v0[3]); w.z = cvt_pk_bf16(v1[0], v1[1]); w.w = cvt_pk_bf16(v1[2], v1[3]);
                    *(u32x4*)(rowp + bj * HALF) = w; } }
    }
};

struct Epi2 {
    static constexpr bool PERM = true, AFTER_DRAIN = false;
    const bf16_t* OA; const bf16_t* OR; bf16_t* A1; bf16_t* A2; bf16_t* SGA; bf16_t* SGB;
    __device__ __forceinline__ void operator()(const f32x4 (&acc)[2][2][4][2], const Unit& u, int wr, int wc, int fr, int fq) const {
        const int row0 = u.pm * BM + wr * 64 + fr;
        const bf16_t* mul; bf16_t* dst; int ldc, colt;
        if (u.pn < 2) { mul = OA; dst = A1; ldc = 512; colt = u.pn * BM; }
        else if (u.pn < 4) { mul = OR; dst = A2; ldc = 512; colt = (u.pn - 2) * BM; }
        else if (u.pn < 8) { mul = nullptr; dst = SGA; ldc = 1024; colt = (u.pn - 4) * BM; }
        else { mul = nullptr; dst = SGB; ldc = 1024; colt = (u.pn - 8) * BM; }
        const int col0 = colt + wc * 32 + 8 * fq;
#pragma unroll
        for (int ai = 0; ai < 2; ++ai)
#pragma unroll
            for (int m = 0; m < 4; ++m) { const size_t off = (size_t)(row0 + ai * HALF + m * 16) * ldc + col0;
#pragma unroll
                for (int bj = 0; bj < 2; ++bj) { const f32x4 z0 = acc[ai][bj][m][0], z1 = acc[ai][bj][m][1];
                    float f[8];
#pragma unroll
                    for (int e = 0; e < 4; ++e) { f[e] = sigmoid_f(z0[e]); f[4 + e] = sigmoid_f(z1[e]); }
                    if (mul) { const u32x4 o = *(const u32x4*)(mul + off + bj * HALF);
#pragma unroll
                        for (int e = 0; e < 4; ++e) { f[e] *= z0[e]; f[4 + e] *= z1[e]; }
                        f[0] *= bf_lo(o.x); f[1] *= bf_hi(o.x); f[2] *= bf_lo(o.y); f[3] *= bf_hi(o.y); f[4] *= bf_lo(o.z); f[5] *= bf_hi(o.z); f[6] *= bf_lo(o.w); f[7] *= bf_hi(o.w); }
                    u32x4 w; w.x = cvt_pk_bf16(f[0], f[1]); w.y = cvt_pk_bf16(f[2], f[3]); w.z = cvt_pk_bf16(f[4], f[5]); w.w = cvt_pk_bf16(f[6], f[7]);
                    *(u32x4*)(dst + off + bj * HALF) = w; } }
    }
};

template <bool ADD> struct EpiMerge {
    static constexpr bool PERM = true, AFTER_DRAIN = false;
    const bf16_t* SG; bf16_t* MG;
    __device__ __forceinline__ void operator()(const f32x4 (&acc)[2][2][4][2], const Unit& u, int wr, int wc, int fr, int fq) const {
        const int row0 = u.pm * BM + wr * 64 + fr, col0 = u.pn * BM + wc * 32 + 8 * fq;
#pragma unroll
        for (int ai = 0; ai < 2; ++ai)
#pragma unroll
            for (int m = 0; m < 4; ++m) { const size_t off = (size_t)(row0 + ai * HALF + m * 16) * 1024 + col0;
#pragma unroll
                for (int bj = 0; bj < 2; ++bj) { const f32x4 z0 = acc[ai][bj][m][0], z1 = acc[ai][bj][m][1];
                    const u32x4 g = *(const u32x4*)(SG + off + bj * HALF);
                    float f[8];
                    f[0] = z0[0] * bf_lo(g.x); f[1] = z0[1] * bf_hi(g.x); f[2] = z0[2] * bf_lo(g.y); f[3] = z0[3] * bf_hi(g.y);
                    f[4] = z1[0] * bf_lo(g.z); f[5] = z1[1] * bf_hi(g.z); f[6] = z1[2] * bf_lo(g.w); f[7] = z1[3] * bf_hi(g.w);
                    if (ADD) { const u32x4 p = *(const u32x4*)(MG + off + bj * HALF);
                        f[0] += bf_lo(p.x); f[1] += bf_hi(p.x); f[2] += bf_lo(p.y); f[3] += bf_hi(p.y); f[4] += bf_lo(p.z); f[5] += bf_hi(p.z); f[6] += bf_lo(p.w); f[7] += bf_hi(p.w); }
                    u32x4 w; w.x = cvt_pk_bf16(f[0], f[1]); w.y = cvt_pk_bf16(f[2], f[3]); w.z = cvt_pk_bf16(f[4], f[5]); w.w = cvt_pk_bf16(f[6], f[7]);
                    *(u32x4*)(MG + off + bj * HALF) = w; } }
    }
};

struct EpiOut {
    static constexpr bool PERM = true, AFTER_DRAIN = false;
    float* OUT; PG8_LAS float* ss;
    __device__ __forceinline__ void operator()(const f32x4 (&acc)[2][2][4][2], const Unit& u, int wr, int wc, int fr, int fq) const {
        const int row0 = u.pm * BM + wr * 64 + fr, col0 = u.pn * BM + wc * 32 + 8 * fq;
#pragma unroll
        for (int ai = 0; ai < 2; ++ai)
#pragma unroll
            for (int m = 0; m < 4; ++m) { float* rowp = OUT + (size_t)(row0 + ai * HALF + m * 16) * 1024 + col0; float q = 0.f;
#pragma unroll
                for (int bj = 0; bj < 2; ++bj) { const f32x4 z0 = acc[ai][bj][m][0], z1 = acc[ai][bj][m][1];
                    q += (z0[0] * z0[0] + z0[1] * z0[1]) + (z0[2] * z0[2] + z0[3] * z0[3]) + (z1[0] * z1[0] + z1[1] * z1[1]) + (z1[2] * z1[2] + z1[3] * z1[3]);
                    *(f32x4*)(rowp + bj * HALF) = z0; *(f32x4*)(rowp + bj * HALF + 4) = z1; }
                q += __shfl_xor(q, 16); q += __shfl_xor(q, 32);
                if (fq == 0) __hip_atomic_fetch_add(ss + (ai * HALF + wr * 64 + m * 16 + fr), q, __ATOMIC_RELAXED, __HIP_MEMORY_SCOPE_WORKGROUP); }
    }
};

template <class Epi, class Sched, bool ALIGN_EPI = false, bool SP2 = false>
__device__ __forceinline__ void gemm_phase(PG8_LAS unsigned char* lds, const Gemm g, const Sched& S, const Epi& E) {
    const int tid = threadIdx.x, wid = __builtin_amdgcn_readfirstlane(tid >> 6), lane = tid & 63, wr = wid >> 2, wc = wid & 3, fr = lane & 15, fq = lane >> 4;
    const int K = g.K, nt = K / BK;
    unsigned voffA[2], voffB[2];
#pragma unroll
    for (int i = 0; i < 2; ++i) { int R, C; stage_rc(tid * 16 + i * 8192, R, C); const int Rb = Epi::PERM ? ((R & ~31) + perm32(R & 31)) : R;
        voffA[i] = (unsigned)(R * K + C) * 2u; voffB[i] = (unsigned)(Rb * K + C) * 2u; }
    const size_t kstep = (size_t)(BK * 2);
    const size_t hstep = (size_t)HALF * K * 2;
    const size_t tstep = 2 * hstep;
    const unsigned ldsw = (unsigned)wid * 1024u;
    const int aoff = lds_byte(wr * 64 + fr, fq * 8), boff = lds_byte(wc * 32 + fr, fq * 8);
#define PG8_SA(b, h) (((b) * 2 + (h)) * HTB)
#define PG8_SB(b, h) ((4 + (b) * 2 + (h)) * HTB)
#define PG8_STAGE(bufoff, gbase, voff) do { _Pragma("unroll") for (int _i = 0; _i < 2; ++_i) \
        __builtin_amdgcn_global_load_lds((const unsigned*)((const char*)(gbase) + (voff)[_i]), (PG8_LAS unsigned*)(lds + (bufoff) + ldsw + _i * 8192), 16, 0, 0); } while (0)
#define PG8_LDA(dst, b, h) do { _Pragma("unroll") for (int m = 0; m < 4; ++m) _Pragma("unroll") for (int k = 0; k < 2; ++k) dst[m][k] = *(const PG8_LAS bf16x8*)(lds + PG8_SA(b, h) + aoff + m * 2048 + k * 1024); } while (0)
#define PG8_LDB(dst, b, h) do { _Pragma("unroll") for (int n = 0; n < 2; ++n) _Pragma("unroll") for (int k = 0; k < 2; ++k) dst[n][k] = *(const PG8_LAS bf16x8*)(lds + PG8_SB(b, h) + boff + n * 2048 + k * 1024); } while (0)
#define PG8_MMA(ai, bj, At, Bt) do { __builtin_amdgcn_s_setprio(1); _Pragma("unroll") for (int m = 0; m < 4; ++m) _Pragma("unroll") for (int n = 0; n < 2; ++n) _Pragma("unroll") for (int k = 0; k < 2; ++k) \
        acc[ai][bj][m][n] = __builtin_amdgcn_mfma_f32_16x16x32_bf16(Bt[n][k], At[m][k], acc[ai][bj][m][n], 0, 0, 0); __builtin_amdgcn_s_setprio(0); } while (0)
#define PG8_WAIT_V(n) asm volatile("s_waitcnt vmcnt(" #n ")" ::: "memory")
#define PG8_WAIT_L(n) asm volatile("s_waitcnt lgkmcnt(" #n ")" ::: "memory")
#define PG8_BAR __builtin_amdgcn_s_barrier()
#define PG8_SCHED __builtin_amdgcn_sched_barrier(0)
    Unit cur, nxt; int ui = 0;
    if (!S.next(0, cur)) return;
    f32x4 acc[2][2][4][2];
#pragma unroll
    for (int a = 0; a < 2; ++a)
#pragma unroll
        for (int b = 0; b < 2; ++b)
#pragma unroll
            for (int m = 0; m < 4; ++m)
#pragma unroll
                for (int n = 0; n < 2; ++n) acc[a][b][m][n] = (f32x4){0.f, 0.f, 0.f, 0.f};
    bf16x8 At[4][2], B0[2][2], B1[2][2];
    const char* cA = (const char*)g.A + (size_t)cur.pm * tstep; const char* cB = (const char*)g.Bt + (size_t)cur.pn * tstep;
    S.a_ready(cur);
    if constexpr (SP2) {
        PG8_STAGE(PG8_SB(0, 0), cB, voffB); PG8_STAGE(PG8_SB(0, 1), cB + hstep, voffB); PG8_STAGE(PG8_SA(0, 0), cA, voffA); PG8_STAGE(PG8_SA(0, 1), cA + hstep, voffA);
        if (wr == 1) PG8_BAR;
        PG8_WAIT_V(2); PG8_BAR;
        PG8_STAGE(PG8_SB(1, 0), cB + kstep, voffB); PG8_STAGE(PG8_SA(1, 0), cA + kstep, voffA); PG8_STAGE(PG8_SB(1, 1), cB + hstep + kstep, voffB);
        PG8_WAIT_V(6); PG8_BAR;
    } else {
        PG8_STAGE(PG8_SB(0, 0), cB, voffB); PG8_STAGE(PG8_SA(0, 0), cA, voffA); PG8_STAGE(PG8_SB(0, 1), cB + hstep, voffB); PG8_STAGE(PG8_SA(0, 1), cA + hstep, voffA);
        if (wr == 1) PG8_BAR;
        PG8_WAIT_V(4); PG8_BAR;
        PG8_STAGE(PG8_SB(1, 0), cB + kstep, voffB); PG8_STAGE(PG8_SA(1, 0), cA + kstep, voffA); PG8_STAGE(PG8_SB(1, 1), cB + hstep + kstep, voffB);
        PG8_WAIT_V(6); PG8_BAR;
    }
    for (;;) {
        const bool has_next = S.next(ui + 1, nxt);
        const char* nA = has_next ? (const char*)g.A + (size_t)nxt.pm * tstep : cA; const char* nB = has_next ? (const char*)g.Bt + (size_t)nxt.pn * tstep : cB;
        for (int t = 0; t < nt; t += 2) {
            const bool last = (t == nt - 2);
            const char* a1 = cA + (size_t)(t + 1) * kstep;
            const char* a2 = last ? nA : cA + (size_t)(t + 2) * kstep; const char* b2 = last ? nB : cB + (size_t)(t + 2) * kstep;
            const char* a3 = a2 + kstep; const char* b3 = b2 + kstep;
            if (last && has_next) S.a_ready(nxt);
            if constexpr (SP2) {
            PG8_LDB(B0, 0, 0); PG8_LDB(B1, 0, 1); PG8_SCHED; PG8_LDA(At, 0, 0); PG8_STAGE(PG8_SA(1, 1), a1 + hstep, voffA);
            PG8_WAIT_V(8); PG8_WAIT_L(0); PG8_BAR; PG8_MMA(0, 0, At, B0); PG8_MMA(0, 1, At, B1); PG8_BAR; PG8_SCHED;
            PG8_LDA(At, 0, 1); PG8_STAGE(PG8_SB(0, 0), b2, voffB); PG8_STAGE(PG8_SB(0, 1), b2 + hstep, voffB); PG8_STAGE(PG8_SA(0, 0), a2, voffA);
            PG8_WAIT_V(8); PG8_WAIT_L(0); PG8_BAR; PG8_MMA(1, 0, At, B0); PG8_MMA(1, 1, At, B1); PG8_BAR; PG8_SCHED;
            PG8_LDB(B0, 1, 0); PG8_LDB(B1, 1, 1); PG8_SCHED; PG8_LDA(At, 1, 0); PG8_STAGE(PG8_SA(0, 1), a2 + hstep, voffA);
            PG8_WAIT_V(8); PG8_WAIT_L(0); PG8_BAR; PG8_MMA(0, 0, At, B0); PG8_MMA(0, 1, At, B1); PG8_BAR; PG8_SCHED;
            PG8_LDA(At, 1, 1); PG8_STAGE(PG8_SB(1, 0), b3, voffB); PG8_STAGE(PG8_SB(1, 1), b3 + hstep, voffB); PG8_STAGE(PG8_SA(1, 0), a3, voffA);
            PG8_WAIT_V(8); PG8_WAIT_L(0); PG8_BAR; PG8_MMA(1, 0, At, B0); PG8_MMA(1, 1, At, B1); PG8_BAR; PG8_SCHED;
            } else {
            PG8_LDB(B0, 0, 0); PG8_SCHED; PG8_LDA(At, 0, 0); PG8_STAGE(PG8_SA(1, 1), a1 + hstep, voffA);
            PG8_WAIT_L(8); PG8_BAR; PG8_WAIT_L(0); PG8_MMA(0, 0, At, B0); PG8_BAR; PG8_SCHED;
            PG8_LDB(B1, 0, 1); PG8_STAGE(PG8_SB(0, 0), b2, voffB);
            PG8_BAR; PG8_WAIT_L(0); PG8_MMA(0, 1, At, B1); PG8_BAR;
            PG8_LDA(At, 0, 1); PG8_STAGE(PG8_SA(0, 0), a2, voffA);
            PG8_BAR; PG8_WAIT_L(0); PG8_MMA(1, 0, At, B0); PG8_BAR; PG8_SCHED;
            PG8_STAGE(PG8_SB(0, 1), b2 + hstep, voffB);
            PG8_WAIT_V(6); PG8_BAR; PG8_MMA(1, 1, At, B1); PG8_BAR;
            PG8_LDB(B0, 1, 0); PG8_SCHED; PG8_LDA(At, 1, 0); PG8_STAGE(PG8_SA(0, 1), a2 + hstep, voffA);
            PG8_WAIT_L(8); PG8_BAR; PG8_WAIT_L(0); PG8_MMA(0, 0, At, B0); PG8_BAR; PG8_SCHED;
            PG8_LDB(B1, 1, 1); PG8_STAGE(PG8_SB(1, 0), b3, voffB);
            PG8_BAR; PG8_WAIT_L(0); PG8_MMA(0, 1, At, B1); PG8_BAR;
            PG8_LDA(At, 1, 1); PG8_STAGE(PG8_SA(1, 0), a3, voffA);
            PG8_BAR; PG8_WAIT_L(0); PG8_MMA(1, 0, At, B0); PG8_BAR; PG8_SCHED;
            PG8_STAGE(PG8_SB(1, 1), b3 + hstep, voffB);
            PG8_WAIT_V(6); PG8_BAR; PG8_MMA(1, 1, At, B1); PG8_BAR;
            }
        }
        if constexpr (ALIGN_EPI) { if (wr == 0) PG8_BAR; }
        if constexpr (!Epi::AFTER_DRAIN) { E(acc, cur, wr, wc, fr, fq); S.done(cur); }
        if (!has_next) break;
#pragma unroll
        for (int a = 0; a < 2; ++a)
#pragma unroll
            for (int b = 0; b < 2; ++b)
#pragma unroll
                for (int m = 0; m < 4; ++m)
#pragma unroll
                    for (int n = 0; n < 2; ++n) acc[a][b][m][n] = (f32x4){0.f, 0.f, 0.f, 0.f};
        cur = nxt; cA = nA; cB = nB; ++ui;
        if constexpr (ALIGN_EPI) { if (wr == 1) PG8_BAR; }
    }
    PG8_WAIT_V(0);
    if constexpr (!ALIGN_EPI) { if (wr == 0) PG8_BAR; }
    PG8_BAR;
    if constexpr (Epi::AFTER_DRAIN) { E.fused(acc, cur, wr, wc, fr, fq, lds, wid, lane); S.done(cur); }
#undef PG8_SA
#undef PG8_SB
#undef PG8_STAGE
#undef PG8_LDA
#undef PG8_LDB
#undef PG8_MMA
#undef PG8_WAIT_V
#undef PG8_WAIT_L
#undef PG8_BAR
#undef PG8_SCHED
}
}

constexpr int NWAVES = 8;
constexpr int BATCH = 32, SEQ = 2048, D = 1024, M = BATCH * SEQ;
constexpr int NQKV = 4608, RW_LD = 1792, LDW_IN = 9344;
constexpr int N1 = 6400, N2 = 3072, WT1_ROWS = N1 + N2;
constexpr int OFF_ATTN_GATE = 4608, OFF_RWKV = 5120, OFF_RWKV_GATE = 6784, OFF_MERGE = 7296;
constexpr float RMS_EPS = 1e-6f, GN_EPS = 64e-5f;
constexpr float LOG2E = 1.4426950408889634f;

constexpr size_t MiB = 1u << 20;
constexpr size_t WS_CTL = 0, CTL_ZERO_BYTES = 1 * MiB;
constexpr size_t WS_WT1 = 2 * MiB, WS_WTA = 22 * MiB, WS_WTB = 23 * MiB, WS_WTO = 24 * MiB, WS_LSE = 26 * MiB;
constexpr size_t WS_H = 32 * MiB, WS_QKV = 160 * MiB, WS_RW = 736 * MiB, WS_END = 960 * MiB;
constexpr size_t WS_SGA = 160 * MiB, WS_SGB = 288 * MiB, WS_A1 = 416 * MiB, WS_A2 = 480 * MiB, WS_MG = 544 * MiB;
static_assert(WS_WT1 + (size_t)WT1_ROWS * D * 2 <= WS_WTA && WS_LSE + (size_t)3 * M * 8 * 4 <= WS_H && WS_H + (size_t)M * D * 2 <= WS_QKV && WS_QKV + (size_t)M * NQKV * 2 <= WS_RW && WS_RW + (size_t)M * RW_LD * 2 <= WS_END && WS_MG + (size_t)M * D * 2 <= WS_RW, "d_ws map");
constexpr size_t OUT_OA = 0, OUT_OR = 64 * MiB;
constexpr int CW_BAR = 4096;

constexpr int RING_BYTES = 131072;
constexpr int LDSCTL_OFF = RING_BYTES, MISC_OFF = LDSCTL_OFF + 320, SS_OFF = MISC_OFF + 128;
constexpr int LDS_BYTES = 147456;
static_assert(SS_OFF + 1024 <= LDS_BYTES, "LDS map");

#define GAS __attribute__((address_space(1)))
#define LAS __attribute__((address_space(3)))
typedef unsigned short bf16;
typedef unsigned v4u __attribute__((ext_vector_type(4)));
typedef unsigned v2u __attribute__((ext_vector_type(2)));
typedef float f32x4 __attribute__((ext_vector_type(4)));
typedef short bf16x8 __attribute__((ext_vector_type(8)));
typedef short s16x4 __attribute__((ext_vector_type(4)));
typedef GAS unsigned gu32;
#define LDS_WAIT() asm volatile("s_waitcnt lgkmcnt(0)" ::: "memory")
#define VM_WAIT() asm volatile("s_waitcnt vmcnt(0)" ::: "memory")
__device__ __forceinline__ unsigned f2bf(float f) { unsigned u = __builtin_bit_cast(unsigned, f); return (u + 0x7fffu + ((u >> 16) & 1u)) >> 16; }
__device__ __forceinline__ unsigned pk2(float lo, float hi) { return f2bf(lo) | (f2bf(hi) << 16); }
__device__ __forceinline__ float bflo(unsigned w) { return __builtin_bit_cast(float, w << 16); }
__device__ __forceinline__ float bfhi(unsigned w) { return __builtin_bit_cast(float, w & 0xffff0000u); }
template <int CTRL> __device__ __forceinline__ float dpp_f(float v) { return __builtin_bit_cast(float, __builtin_amdgcn_update_dpp(0, __builtin_bit_cast(int, v), CTRL, 0xF, 0xF, false)); }
__device__ __forceinline__ float sum4(float v) { v += dpp_f<0xB1>(v); v += dpp_f<0x4E>(v); return v; }
__device__ __forceinline__ float sum8(float v) { v = sum4(v); v += dpp_f<0x141>(v); return v; }
__device__ __forceinline__ float sum16(float v) { v = sum8(v); v += dpp_f<0x140>(v); return v; }
__device__ __forceinline__ float max16(float v) { v = fmaxf(v, dpp_f<0xB1>(v)); v = fmaxf(v, dpp_f<0x4E>(v)); v = fmaxf(v, dpp_f<0x141>(v)); v = fmaxf(v, dpp_f<0x140>(v)); return v; }
__device__ __forceinline__ float sigm(float z) { return __builtin_amdgcn_rcpf(1.0f + __builtin_amdgcn_exp2f(-LOG2E * z)); }
#define XB_TMO      128
#define XB_XCNT(j)  (256  + 64 * (j))
#define XB_XSUB(j)  (1280 + 64 * (j))
#define XB_XGEN(j)  (2304 + 64 * (j))
#define XB_TOP      3328
#define XB_TOPGEN   3392
#define XCD_BAR_WORDS 3456
#define XB_SPIN_CAP (1u << 18)

__device__ __forceinline__ unsigned xb_ld(unsigned* p)              { return __hip_atomic_load(p, __ATOMIC_RELAXED, __HIP_MEMORY_SCOPE_AGENT); }
__device__ __forceinline__ unsigned xb_add(unsigned* p, unsigned v) { return __hip_atomic_fetch_add(p, v, __ATOMIC_RELAXED, __HIP_MEMORY_SCOPE_AGENT); }
__device__ __forceinline__ unsigned xb_xcc_id() { return (unsigned)__builtin_amdgcn_s_getreg((3 << 11) | 20) & 0xFu; }
#define XB_SPIN(cond, bar) do { unsigned _sp = 0; while (cond) { __builtin_amdgcn_s_sleep(1); \
    if ((++_sp & 255u) == 0u) { if (xb_ld(&(bar)[XB_TMO])) break; if (_sp > XB_SPIN_CAP) { atomicAdd(&(bar)[XB_TMO], 1u); break; } } } } while (0)

struct XcdBarrier {
    unsigned* bar; unsigned x;
    volatile LAS unsigned* st;
};

__device__ __forceinline__ XcdBarrier xcd_barrier_post(unsigned* bar, volatile LAS unsigned* st) {
    XcdBarrier b; b.bar = bar; b.x = xb_xcc_id(); b.st = st;
    if (threadIdx.x == 0) (void)xb_add(&bar[XB_XCNT(b.x)], 1u);
    return b;
}
__device__ __forceinline__ void xcd_barrier_complete(unsigned* bar, unsigned x, unsigned& nloc, unsigned& nx) {
    const unsigned G = gridDim.x * gridDim.y * gridDim.z;
    unsigned sum, cnt, mine, sp = 0u;
    for (;;) {
        sum = 0u; cnt = 0u; mine = 0u;
#pragma unroll
        for (unsigned j = 0; j < 16; ++j) { const unsigned c = xb_ld(&bar[XB_XCNT(j)]); sum += c; cnt += (c > 0u) ? 1u : 0u; mine = (j == x) ? c : mine; }
        if (sum == G) break;
        __builtin_amdgcn_s_sleep(1);
        if ((++sp & 255u) == 0u) { if (xb_ld(&bar[XB_TMO])) break; if (sp > XB_SPIN_CAP) { atomicAdd(&bar[XB_TMO], 1u); break; } }
    }
    nloc = mine > 0u ? mine : 1u; nx = cnt > 0u ? cnt : 1u;
}

__device__ __forceinline__ void xcd_barrier(const XcdBarrier& b) {
    asm volatile("s_waitcnt vmcnt(0)" ::: "memory");
    __syncthreads();
    if (threadIdx.x == 0) {
        unsigned* bar = b.bar;
        __builtin_amdgcn_s_waitcnt(0);
        unsigned nloc = b.st[0], nx = b.st[1];
        if (nloc == 0u) { xcd_barrier_complete(bar, b.x, nloc, nx); b.st[0] = nloc; b.st[1] = nx; }
        const unsigned old = xb_add(&bar[XB_XSUB(b.x)], 1u);
        const unsigned gen = old / nloc;
        if (old + 1u == (gen + 1u) * nloc) {
            __builtin_amdgcn_fence(__ATOMIC_RELEASE, "agent");
            asm volatile("s_waitcnt vmcnt(0)" ::: "memory");
            const unsigned og = xb_add(&bar[XB_TOP], 1u);
            const unsigned tg = og / nx;
            if (og + 1u == (tg + 1u) * nx) xb_add(&bar[XB_TOPGEN], 1u);
            else XB_SPIN(xb_ld(&bar[XB_TOPGEN]) == tg, bar);
            __builtin_amdgcn_fence(__ATOMIC_ACQUIRE, "agent");
            xb_add(&bar[XB_XGEN(b.x)], 1u);
            asm volatile("s_waitcnt vmcnt(0)" ::: "memory");
        } else {
            XB_SPIN(xb_ld(&bar[XB_XGEN(b.x)]) == gen, bar);
            __builtin_amdgcn_fence(__ATOMIC_ACQUIRE, "agent");
            asm volatile("s_waitcnt vmcnt(0)" ::: "memory");
        }
    }
    __syncthreads();
}

struct Frame {
    LAS unsigned char* lds;
    volatile LAS unsigned* MISC;
    gu32* ctl;
    int tid, lane, wave;
    int vcu, G;
    const float* x; float* out;
    const float *pre_g, *w_in, *rel_bias, *mix, *w0, *w_up, *a0, *a_up, *k_k, *k_a, *r_k, *ln_w, *ln_b, *w_upA, *w_upB, *w_out, *post_g;
    bf16 *WT1, *WTA, *WTB, *WTO, *H, *QKV, *RW, *SGA, *SGB, *A1, *A2, *MG, *OA, *OR;
    float* LSE;
};

__device__ __forceinline__ float wave_sum(float v) {
#pragma unroll
    for (int o = 1; o < 64; o <<= 1) v += __shfl_xor(v, o);
    return v;
}
__device__ __forceinline__ void p0_transpose_item(const float* W, int K, int ldw, int c0, int nblk, bf16* WT, int row_off, LAS float* scr, int item, int lane) {
    const int kb = item / nblk, nb = item % nblk, k0 = 64 * kb, n0 = 32 * nb;
#pragma unroll 8
    for (int i = 0; i < 32; ++i) { const int kk = 2 * i + (lane >> 5); scr[kk * 33 + (lane & 31)] = W[(size_t)(k0 + kk) * ldw + c0 + n0 + (lane & 31)]; }
    LDS_WAIT(); asm volatile("" ::: "memory");
    const int c = lane & 7;
#pragma unroll
    for (int j = 0; j < 4; ++j) { const int n = (lane >> 3) + 8 * j; const LAS float* s = scr + (8 * c) * 33 + n;
        v4u o; o.x = pk2(s[0 * 33], s[1 * 33]); o.y = pk2(s[2 * 33], s[3 * 33]); o.z = pk2(s[4 * 33], s[5 * 33]); o.w = pk2(s[6 * 33], s[7 * 33]);
        *(GAS v4u*)(WT + (size_t)(row_off + n0 + n) * K + k0 + 8 * c) = o; }
    LDS_WAIT(); asm volatile("" ::: "memory");
}
__device__ __forceinline__ void rms_row_to_bf16(Frame& F, const float* xrow, bf16* orow) {
    const GAS f32x4* xr = (const GAS f32x4*)xrow + F.lane; const GAS f32x4* gr = (const GAS f32x4*)F.pre_g + F.lane;
    f32x4 v[4]; float s = 0.f;
#pragma unroll
    for (int j = 0; j < 4; ++j) { v[j] = xr[64 * j]; s += (v[j].x * v[j].x + v[j].y * v[j].y) + (v[j].z * v[j].z + v[j].w * v[j].w); }
    const float rstd = 1.f / sqrtf(wave_sum(s) * (1.f / D) + RMS_EPS);
    GAS unsigned long long* o8 = (GAS unsigned long long*)orow + F.lane;
#pragma unroll
    for (int j = 0; j < 4; ++j) { const f32x4 g = gr[64 * j]; const f32x4 y = v[j] * rstd * g;
        o8[64 * j] = (unsigned long long)pk2(y.x, y.y) | ((unsigned long long)pk2(y.z, y.w) << 32); }
}
__device__ __forceinline__ void p0_prologue(Frame& F) {
    LAS float* scr = (LAS float*)(F.lds + F.wave * 16384);
    const int gw = F.vcu * NWAVES + F.wave, NGW = F.G * NWAVES;
    constexpr int I1 = 16 * 144, I2 = 16 * 52, I4 = 16 * 16, I5 = 16 * 16, I6 = 16 * 64, I7 = 8 * 32, I8 = 8 * 32, I9 = 16 * 32;
    constexpr int NITEMS = I1 + I2 + I4 + I5 + I6 + I7 + I8 + I9;
    for (int it = gw; it < NITEMS; it += NGW) {
        int r = it;
        if (r < I1) { p0_transpose_item(F.w_in, D, LDW_IN, 0, 144, F.WT1, 0, scr, r, F.lane); continue; } r -= I1;
        if (r < I2) { p0_transpose_item(F.w_in, D, LDW_IN, OFF_RWKV, 52, F.WT1, 4608, scr, r, F.lane); continue; } r -= I2;
        if (r < I4) { p0_transpose_item(F.w_in, D, LDW_IN, OFF_ATTN_GATE, 16, F.WT1, N1, scr, r, F.lane); continue; } r -= I4;
        if (r < I5) { p0_transpose_item(F.w_in, D, LDW_IN, OFF_RWKV_GATE, 16, F.WT1, N1 + 512, scr, r, F.lane); continue; } r -= I5;
        if (r < I6) { p0_transpose_item(F.w_in, D, LDW_IN, OFF_MERGE, 64, F.WT1, N1 + 1024, scr, r, F.lane); continue; } r -= I6;
        if (r < I7) { p0_transpose_item(F.w_upA, 512, D, 0, 32, F.WTA, 0, scr, r, F.lane); continue; } r -= I7;
        if (r < I8) { p0_transpose_item(F.w_upB, 512, D, 0, 32, F.WTB, 0, scr, r, F.lane); continue; } r -= I8;
        p0_transpose_item(F.w_out, D, D, 0, 32, F.WTO, 0, scr, r, F.lane);
    }
    { const int gt = F.vcu * (NWAVES * 64) + F.tid, NT = F.G * NWAVES * 64;
      for (int i = gt; i < 16384; i += NT) *((GAS v4u*)(F.WT1 + (size_t)6272 * D) + i) = (v4u){0u, 0u, 0u, 0u}; }
    for (int m = gw; m < M; m += NGW) rms_row_to_bf16(F, F.x + (size_t)m * D, F.H + (size_t)m * D);
}

namespace att {
constexpr int KSTR = 144;
constexpr int KS_OFF = 0, VS_OFF = 272 * KSTR, PS_OFF = 2 * 272 * KSTR, PSTR = 336, PS_WAVE = 16 * PSTR, BIAS_OFF = PS_OFF + 8 * PS_WAVE, END_OFF = BIAS_OFF + 544;
static_assert(END_OFF <= RING_BYTES, "attention LDS");
typedef short v4i16_t __attribute__((ext_vector_type(4)));
__device__ __forceinline__ s16x4 vtr(LAS const unsigned char* p) { return __builtin_bit_cast(s16x4, __builtin_amdgcn_ds_read_tr16_b64_v4i16((LAS v4i16_t*)p)); }
__device__ __forceinline__ int t5_bucket(int d) {
    if (d < 16) return d;
    int b = 16;
    b += (d >= 22); b += (d >= 30); b += (d >= 40); b += (d >= 54); b += (d >= 73); b += (d >= 99); b += (d >= 134); b += (d >= 182);
    b += (d >= 246); b += (d >= 332); b += (d >= 450); b += (d >= 609); b += (d >= 825); b += (d >= 1117); b += (d >= 1513);
    return b;
}

__device__ __forceinline__ void attn_phase(Frame& F) {
    LAS unsigned char* lds = F.lds;
    const int tid = F.tid, lane = F.lane, w = F.wave, c = lane & 15, q = lane >> 4;
    const int b = F.vcu >> 3, h = F.vcu & 7;
    if (F.vcu >= BATCH * 8) return;
    for (int i = tid; i < 2 * 16 * (KSTR / 4); i += NWAVES * 64) { const int which = i / (16 * (KSTR / 4)), o = i % (16 * (KSTR / 4)); *(LAS unsigned*)(lds + (which ? VS_OFF : KS_OFF) + 256 * KSTR + o * 4) = 0u; }
    LAS float* bias2 = (LAS float*)(lds + BIAS_OFF);
    LAS unsigned char* PSw = lds + PS_OFF + w * PS_WAVE;
    const float NEG_INF = -__builtin_inff();
    for (int g = 0; g < 3; ++g) {
        const int dil = (g == 0) ? 1 : (g == 1) ? 4 : 16, nb = (SEQ / dil) / 128;
        __syncthreads();
        if (tid <= 128) bias2[tid] = F.rel_bias[t5_bucket(tid * dil) * 24 + g * 8 + h] * LOG2E;
        __syncthreads();
        float bl[10][4];
#pragma unroll
        for (int n16 = 0; n16 < 10; ++n16)
#pragma unroll
            for (int reg = 0; reg < 4; ++reg) { const int rel = 128 + 4 * q + reg - 16 * n16 - c; const int rc = rel < 0 ? 0 : (rel > 128 ? 128 : rel);
                const float bv = bias2[rc]; bl[n16][reg] = (rel >= 0 && rel <= 128) ? bv : NEG_INF; }
        const bf16* Qg = F.QKV + (size_t)b * SEQ * NQKV + g * 512 + h * 64;
        float* LSEg = F.LSE + ((size_t)g * M + (size_t)b * SEQ) * 8 + h;
        for (int r = 0; r < dil; ++r)
            for (int n = 0; n < nb; ++n) {
                v4u kreg[4], vreg[4];
#pragma unroll
                for (int it = 0; it < 4; ++it) { const int idx = tid + 512 * it, row = idx >> 3, ch = idx & 7, j = (n - 1) * 128 + row;
                    kreg[it] = (v4u){0u, 0u, 0u, 0u}; vreg[it] = (v4u){0u, 0u, 0u, 0u};
                    if (j >= 0) { const bf16* p = Qg + (size_t)(j * dil + r) * NQKV + ch * 8; kreg[it] = *(const GAS v4u*)(p + 1536); vreg[it] = *(const GAS v4u*)(p + 3072); } }
                bf16x8 aq[2];
                { const bf16* qp = Qg + (size_t)((n * 128 + 16 * w + c) * dil + r) * NQKV + 8 * q;
                  aq[0] = *(const GAS bf16x8*)(qp); aq[1] = *(const GAS bf16x8*)(qp + 32); }
#pragma unroll
                for (int it = 0; it < 4; ++it) { const int idx = tid + 512 * it, row = idx >> 3, ch = idx & 7;
                    *(LAS v4u*)(lds + KS_OFF + row * KSTR + ch * 16) = kreg[it]; *(LAS v4u*)(lds + VS_OFF + row * KSTR + ch * 16) = vreg[it]; }
                __syncthreads();
                f32x4 s[10];
#pragma unroll
                for (int n16 = 0; n16 < 10; ++n16) { s[n16] = (f32x4){0.f, 0.f, 0.f, 0.f};
#pragma unroll
                    for (int ks = 0; ks < 2; ++ks) { const bf16x8 bk = *(const LAS bf16x8*)(lds + KS_OFF + (16 * w + 16 * n16 + c) * KSTR + (32 * ks + 8 * q) * 2);
                        s[n16] = __builtin_amdgcn_mfma_f32_16x16x32_bf16(aq[ks], bk, s[n16], 0, 0, 0); } }
                float mx[4] = {NEG_INF, NEG_INF, NEG_INF, NEG_INF};
#pragma unroll
                for (int n16 = 0; n16 < 10; ++n16) { const bool ok = (n > 0) || (16 * w + 16 * n16 + c >= 128);
#pragma unroll
                    for (int reg = 0; reg < 4; ++reg) { const float v = ok ? s[n16][reg] + bl[n16][reg] : NEG_INF; s[n16][reg] = v; mx[reg] = fmaxf(mx[reg], v); } }
#pragma unroll
                for (int reg = 0; reg < 4; ++reg) mx[reg] = max16(mx[reg]);
                float ls[4] = {0.f, 0.f, 0.f, 0.f};
#pragma unroll
                for (int n16 = 0; n16 < 10; ++n16)
#pragma unroll
                    for (int reg = 0; reg < 4; ++reg) { const float p = __builtin_amdgcn_exp2f(s[n16][reg] - mx[reg]); ls[reg] += p;
                        *(LAS unsigned short*)(PSw + (4 * q + reg) * PSTR + (16 * n16 + c) * 2) = (unsigned short)f2bf(p); }
#pragma unroll
                for (int reg = 0; reg < 4; ++reg) ls[reg] = sum16(ls[reg]);
                f32x4 o[4];
#pragma unroll
                for (int nd = 0; nd < 4; ++nd) o[nd] = (f32x4){0.f, 0.f, 0.f, 0.f};
#pragma unroll
                for (int ks = 0; ks < 5; ++ks) { const bf16x8 pa = *(const LAS bf16x8*)(PSw + c * PSTR + (32 * ks + 8 * q) * 2);
                    LAS const unsigned char* vb = lds + VS_OFF + (16 * w + 32 * ks + 8 * q + (c >> 2)) * KSTR + (c & 3) * 8;
#pragma unroll
                    for (int nd = 0; nd < 4; ++nd) { const s16x4 lo = vtr(vb + nd * 32), hi = vtr(vb + nd * 32 + 4 * KSTR);
                        const bf16x8 bv = (bf16x8){lo[0], lo[1], lo[2], lo[3], hi[0], hi[1], hi[2], hi[3]};
                        o[nd] = __builtin_amdgcn_mfma_f32_16x16x32_bf16(pa, bv, o[nd], 0, 0, 0); } }
                float inv[4];
#pragma unroll
                for (int reg = 0; reg < 4; ++reg) inv[reg] = __builtin_amdgcn_rcpf(ls[reg]);
#pragma unroll
                for (int nd = 0; nd < 4; ++nd)
#pragma unroll
                    for (int reg = 0; reg < 4; ++reg) *(LAS unsigned short*)(PSw + (4 * q + reg) * KSTR + (16 * nd + c) * 2) = (unsigned short)f2bf(o[nd][reg] * inv[reg]);
#pragma unroll
                for (int it = 0; it < 2; ++it) { const int id = lane + 64 * it, row = id >> 3, ch = id & 7;
                    const v4u val = *(const LAS v4u*)(PSw + row * KSTR + ch * 16);
                    *(GAS v4u*)(Qg + (size_t)((n * 128 + 16 * w + row) * dil + r) * NQKV + ch * 8) = val; }
                if (c == 0) {
#pragma unroll
                    for (int reg = 0; reg < 4; ++reg) LSEg[(size_t)((n * 128 + 16 * w + 4 * q + reg) * dil + r) * 8] = mx[reg] + __builtin_amdgcn_logf(ls[reg]);
                }
                __syncthreads();
            }
    }
    VM_WAIT(); __syncthreads();
    if (tid == 0) { __builtin_amdgcn_fence(__ATOMIC_ACQUIRE, "agent"); VM_WAIT(); }
    __syncthreads();
    for (int p = tid; p < SEQ * 8; p += NWAVES * 64) { const int t = p >> 3, ch = p & 7; const size_t row = (size_t)b * SEQ + t;
        float l0 = F.LSE[((size_t)0 * M + row) * 8 + h], l1 = F.LSE[((size_t)1 * M + row) * 8 + h], l2 = F.LSE[((size_t)2 * M + row) * 8 + h];
        const float mm = fmaxf(l0, fmaxf(l1, l2)); float w0 = __builtin_amdgcn_exp2f(l0 - mm), w1 = __builtin_amdgcn_exp2f(l1 - mm), w2 = __builtin_amdgcn_exp2f(l2 - mm);
        const float wi = __builtin_amdgcn_rcpf(w0 + w1 + w2); w0 *= wi; w1 *= wi; w2 *= wi;
        const bf16* qp = F.QKV + row * NQKV + h * 64 + ch * 8;
        const v4u a = *(const GAS v4u*)(qp), bb = *(const GAS v4u*)(qp + 512), cc = *(const GAS v4u*)(qp + 1024);
        v4u o;
        o.x = pk2(w0 * bflo(a.x) + w1 * bflo(bb.x) + w2 * bflo(cc.x), w0 * bfhi(a.x) + w1 * bfhi(bb.x) + w2 * bfhi(cc.x));
        o.y = pk2(w0 * bflo(a.y) + w1 * bflo(bb.y) + w2 * bflo(cc.y), w0 * bfhi(a.y) + w1 * bfhi(bb.y) + w2 * bfhi(cc.y));
        o.z = pk2(w0 * bflo(a.z) + w1 * bflo(bb.z) + w2 * bflo(cc.z), w0 * bfhi(a.z) + w1 * bfhi(bb.z) + w2 * bfhi(cc.z));
        o.w = pk2(w0 * bflo(a.w) + w1 * bflo(bb.w) + w2 * bflo(cc.w), w0 * bfhi(a.w) + w1 * bfhi(bb.w) + w2 * bfhi(cc.w));
        *(GAS v4u*)(F.OA + row * 512 + h * 64 + ch * 8) = o; }
    __syncthreads();
}
}

namespace rwkv {
constexpr int TC = 32;
constexpr int WUPT_OFF = 0, AUPT_OFF = 9216, TW_OFF = 18432, AL_OFF = 23040, RAWF_OFF = 27648, VEC_OFF = 52224, Y_OFF = 101376, SSQ_OFF = 109568, BON_OFF = 109696, END_OFF = 109824;
static_assert(END_OFF <= RING_BYTES, "scan LDS");
constexpr int RSTR = 144;

__device__ __forceinline__ void scan_phase(Frame& F) {
    LAS unsigned char* lds = F.lds;
    const int tid = F.tid, lane = F.lane, w = F.wave, c = lane & 15, q = lane >> 4;
    const int b = F.vcu >> 3, h = F.vcu & 7;
    if (F.vcu >= BATCH * 8) return;
    __syncthreads();
    for (int e = tid; e < 64 * 64; e += NWAVES * 64) { const int j = e >> 6, i = e & 63;
        *(LAS unsigned short*)(lds + WUPT_OFF + i * RSTR + j * 2) = (unsigned short)f2bf(F.w_up[j * 512 + h * 64 + i]);
        *(LAS unsigned short*)(lds + AUPT_OFF + i * RSTR + j * 2) = (unsigned short)f2bf(F.a_up[j * 512 + h * 64 + i]); }
    LAS float* RAWF = (LAS float*)(lds + RAWF_OFF);
    LAS float* VEC = (LAS float*)(lds + VEC_OFF);
    LAS float* Y = (LAS float*)(lds + Y_OFF);
    LAS float* SSQ = (LAS float*)(lds + SSQ_OFF);
    LAS float* BON = (LAS float*)(lds + BON_OFF);
    const bf16* RWb = F.RW + (size_t)b * SEQ * RW_LD;
    int ptok[3], pcol[3], prun[3], ppc[3]; bool pok[3];
#pragma unroll
    for (int it = 0; it < 3; ++it) { const int p = tid + 512 * it; pok[it] = p < TC * 40; const int pp = pok[it] ? p : 0; ptok[it] = pp / 40; const int rem = pp % 40; prun[it] = rem >> 3; ppc[it] = rem & 7;
        pcol[it] = (prun[it] < 3 ? prun[it] * 512 + h * 64 : (prun[it] == 3 ? 1536 : 1600)) + ppc[it] * 8; }
    v4u cur[3], prv[3];
#define RW_LOAD(t0) do { _Pragma("unroll") for (int it = 0; it < 3; ++it) { cur[it] = (v4u){0u, 0u, 0u, 0u}; prv[it] = (v4u){0u, 0u, 0u, 0u}; \
        if (pok[it]) { const int t = (t0) + ptok[it]; cur[it] = *(const GAS v4u*)(RWb + (size_t)t * RW_LD + pcol[it]); if (t > 0) prv[it] = *(const GAS v4u*)(RWb + (size_t)(t - 1) * RW_LD + pcol[it]); } } } while (0)
    RW_LOAD(0);
    float S[8];
#pragma unroll
    for (int e = 0; e < 8; ++e) S[e] = 0.f;
    const int srow = tid >> 3, c8 = tid & 7;
    const int hc_e = h * 64 + 16 * (w >> 1) + c;
    const float p_w0 = F.w0[hc_e], p_a0 = F.a0[hc_e], p_kk = F.k_k[hc_e], p_ka = F.k_a[hc_e];
    const int otok = tid >> 4, opart = tid & 15, hc_o = h * 64 + 4 * opart;
    const f32x4 p_kk4 = *(const GAS f32x4*)(F.k_k + hc_o), p_rk4 = *(const GAS f32x4*)(F.r_k + hc_o), p_lnw4 = *(const GAS f32x4*)(F.ln_w + hc_o), p_lnb4 = *(const GAS f32x4*)(F.ln_b + hc_o);
    for (int t0 = 0; t0 < SEQ; t0 += TC) {
#pragma unroll
        for (int it = 0; it < 3; ++it) if (pok[it]) {
            const f32x4 m0 = *(const GAS f32x4*)(F.mix + pcol[it]), m1 = *(const GAS f32x4*)(F.mix + pcol[it] + 4);
            float x[8];
            { const v4u cu = cur[it], pr = prv[it];
              const float cv[8] = {bflo(cu.x), bfhi(cu.x), bflo(cu.y), bfhi(cu.y), bflo(cu.z), bfhi(cu.z), bflo(cu.w), bfhi(cu.w)};
              const float pv[8] = {bflo(pr.x), bfhi(pr.x), bflo(pr.y), bfhi(pr.y), bflo(pr.z), bfhi(pr.z), bflo(pr.w), bfhi(pr.w)};
              const float mv[8] = {m0[0], m0[1], m0[2], m0[3], m1[0], m1[1], m1[2], m1[3]};
#pragma unroll
              for (int e = 0; e < 8; ++e) x[e] = cv[e] + (pv[e] - cv[e]) * mv[e]; }
            if (prun[it] < 3) { LAS float* d = RAWF + (ptok[it] * 3 + prun[it]) * 64 + ppc[it] * 8;
                *(LAS f32x4*)d = (f32x4){x[0], x[1], x[2], x[3]}; *(LAS f32x4*)(d + 4) = (f32x4){x[4], x[5], x[6], x[7]}; }
            else { if (prun[it] == 3) {
#pragma unroll
                    for (int e = 0; e < 8; ++e) { const float ex = __builtin_amdgcn_exp2f(2.0f * LOG2E * x[e]); x[e] = 1.0f - 2.0f * __builtin_amdgcn_rcpf(ex + 1.0f); } }
                v4u o; o.x = pk2(x[0], x[1]); o.y = pk2(x[2], x[3]); o.z = pk2(x[4], x[5]); o.w = pk2(x[6], x[7]);
                *(LAS v4u*)(lds + (prun[it] == 3 ? TW_OFF : AL_OFF) + ptok[it] * RSTR + ppc[it] * 16) = o; }
        }
        __syncthreads();
        if (t0 + TC < SEQ) RW_LOAD(t0 + TC);
        { const f32x4 kv = *(const LAS f32x4*)(RAWF + (otok * 3 + 1) * 64 + 4 * opart); const f32x4 z = kv * p_kk4;
          const float s = sum16((z[0] * z[0] + z[1] * z[1]) + (z[2] * z[2] + z[3] * z[3])); if (opart == 0) SSQ[otok] = s; }
        __syncthreads();
        { const int mt = w & 1, nt = w >> 1;
          f32x4 cw = (f32x4){0.f, 0.f, 0.f, 0.f}, ca = (f32x4){0.f, 0.f, 0.f, 0.f};
#pragma unroll
          for (int ks = 0; ks < 2; ++ks) {
              const bf16x8 atw = *(const LAS bf16x8*)(lds + TW_OFF + (16 * mt + c) * RSTR + (32 * ks + 8 * q) * 2), aal = *(const LAS bf16x8*)(lds + AL_OFF + (16 * mt + c) * RSTR + (32 * ks + 8 * q) * 2);
              const bf16x8 bw = *(const LAS bf16x8*)(lds + WUPT_OFF + (16 * nt + c) * RSTR + (32 * ks + 8 * q) * 2), ba = *(const LAS bf16x8*)(lds + AUPT_OFF + (16 * nt + c) * RSTR + (32 * ks + 8 * q) * 2);
              cw = __builtin_amdgcn_mfma_f32_16x16x32_bf16(atw, bw, cw, 0, 0, 0); ca = __builtin_amdgcn_mfma_f32_16x16x32_bf16(aal, ba, ca, 0, 0, 0); }
          const int i = 16 * nt + c;
#pragma unroll
          for (int reg = 0; reg < 4; ++reg) { const int tok = 16 * mt + 4 * q + reg;
              const float sg = sigm(p_w0 + cw[reg]); const float decay = __builtin_amdgcn_exp2f(-0.6065306597126334f * LOG2E * sg);
              const float al = sigm(p_a0 + ca[reg]);
              const float rr = RAWF[(tok * 3 + 0) * 64 + i], kr = RAWF[(tok * 3 + 1) * 64 + i], vv = RAWF[(tok * 3 + 2) * 64 + i];
              const float kkn = kr * p_kk / fmaxf(sqrtf(SSQ[tok]), 1e-12f);
              const float kp = kr * (1.0f + (al - 1.0f) * p_ka);
              LAS float* vt = VEC + tok * 384 + i;
              vt[0] = decay; vt[64] = -kkn; vt[128] = kkn * al; vt[192] = kp; vt[256] = rr; vt[320] = vv; } }
        __syncthreads();
        { const f32x4 rv = *(const LAS f32x4*)(VEC + otok * 384 + 256 + 4 * opart), kv = *(const LAS f32x4*)(VEC + otok * 384 + 192 + 4 * opart); const f32x4 z = rv * kv * p_rk4;
          const float s = sum16((z[0] + z[1]) + (z[2] + z[3])); if (opart == 0) BON[otok] = s; }
#pragma unroll 2
        for (int t = 0; t < TC; ++t) { const LAS float* vt = VEC + t * 384 + 8 * c8;
            const f32x4 w0 = *(const LAS f32x4*)(vt), w1 = *(const LAS f32x4*)(vt + 4), a0 = *(const LAS f32x4*)(vt + 64), a1 = *(const LAS f32x4*)(vt + 68);
            const f32x4 b0 = *(const LAS f32x4*)(vt + 128), b1 = *(const LAS f32x4*)(vt + 132), k0 = *(const LAS f32x4*)(vt + 192), k1 = *(const LAS f32x4*)(vt + 196);
            const f32x4 r0 = *(const LAS f32x4*)(vt + 256), r1 = *(const LAS f32x4*)(vt + 260); const float vv = VEC[t * 384 + 320 + srow];
            float sa = ((S[0] * a0[0] + S[1] * a0[1]) + (S[2] * a0[2] + S[3] * a0[3])) + ((S[4] * a1[0] + S[5] * a1[1]) + (S[6] * a1[2] + S[7] * a1[3]));
            sa = sum8(sa);
#pragma unroll
            for (int e = 0; e < 4; ++e) { S[e] = S[e] * w0[e] + (sa * b0[e] + vv * k0[e]); S[4 + e] = S[4 + e] * w1[e] + (sa * b1[e] + vv * k1[e]); }
            float y = ((S[0] * r0[0] + S[1] * r0[1]) + (S[2] * r0[2] + S[3] * r0[3])) + ((S[4] * r1[0] + S[5] * r1[1]) + (S[6] * r1[2] + S[7] * r1[3]));
            y = sum8(y);
            if (c8 == 0) Y[t * 64 + srow] = y; }
        __syncthreads();
        { const f32x4 yv = *(const LAS f32x4*)(Y + otok * 64 + 4 * opart);
          const float mu = sum16((yv[0] + yv[1]) + (yv[2] + yv[3])) * (1.0f / 64.0f); const f32x4 dv = yv - mu;
          const float var = sum16((dv[0] * dv[0] + dv[1] * dv[1]) + (dv[2] * dv[2] + dv[3] * dv[3])) * (1.0f / 64.0f);
          const float rs = 1.0f / sqrtf(var + GN_EPS); const float bon = BON[otok];
          const f32x4 vv = *(const LAS f32x4*)(VEC + otok * 384 + 320 + 4 * opart);
          const f32x4 o = dv * rs * p_lnw4 + p_lnb4 + vv * bon;
          v2u ow; ow.x = pk2(o[0], o[1]); ow.y = pk2(o[2], o[3]);
          *(GAS v2u*)(F.OR + ((size_t)b * SEQ + t0 + otok) * 512 + hc_o) = ow; }
    }
#undef RW_LOAD
    __syncthreads();
}
}

#ifndef MK_N_LAUNCHES
#define MK_N_LAUNCHES 1
#endif
constexpr int N_LAUNCHES = MK_N_LAUNCHES;
constexpr int N_PHASES = 5;
struct Args { const float* in[18]; float* out; unsigned char* ws; int ph_lo, ph_hi; };
__global__ void __launch_bounds__(NWAVES * 64, 2) mk_fwd(Args args) {
    extern __shared__ __attribute__((aligned(16))) unsigned char lds[];
    Frame F;
    F.lds = (LAS unsigned char*)lds;
    F.MISC = (volatile LAS unsigned*)(F.lds + MISC_OFF);
    F.tid = threadIdx.x; F.lane = F.tid & 63; F.wave = __builtin_amdgcn_readfirstlane(F.tid >> 6);
    F.G = gridDim.x; { const int bx = blockIdx.x; F.vcu = (F.G % 8 == 0) ? (bx % 8) * (F.G / 8) + bx / 8 : bx; }
    unsigned char* ws = args.ws;
    F.ctl = (gu32*)(ws + WS_CTL);
    F.x = args.in[0]; F.pre_g = args.in[1]; F.w_in = args.in[2]; F.rel_bias = args.in[3]; F.mix = args.in[4]; F.w0 = args.in[5]; F.w_up = args.in[6]; F.a0 = args.in[7]; F.a_up = args.in[8];
    F.k_k = args.in[9]; F.k_a = args.in[10]; F.r_k = args.in[11]; F.ln_w = args.in[12]; F.ln_b = args.in[13]; F.w_upA = args.in[14]; F.w_upB = args.in[15]; F.w_out = args.in[16]; F.post_g = args.in[17];
    F.out = args.out;
    F.WT1 = (bf16*)(ws + WS_WT1); F.WTA = (bf16*)(ws + WS_WTA); F.WTB = (bf16*)(ws + WS_WTB); F.WTO = (bf16*)(ws + WS_WTO); F.LSE = (float*)(ws + WS_LSE);
    F.H = (bf16*)(ws + WS_H); F.QKV = (bf16*)(ws + WS_QKV); F.RW = (bf16*)(ws + WS_RW);
    F.SGA = (bf16*)(ws + WS_SGA); F.SGB = (bf16*)(ws + WS_SGB); F.A1 = (bf16*)(ws + WS_A1); F.A2 = (bf16*)(ws + WS_A2); F.MG = (bf16*)(ws + WS_MG);
    F.OA = (bf16*)((unsigned char*)args.out + OUT_OA); F.OR = (bf16*)((unsigned char*)args.out + OUT_OR);
    for (int u = F.tid; u < (LDS_BYTES - LDSCTL_OFF) / 4; u += NWAVES * 64) ((LAS unsigned*)(F.lds + LDSCTL_OFF))[u] = 0u;
    __syncthreads();
    XcdBarrier bar; bar.bar = (unsigned*)(F.ctl + CW_BAR); bar.x = 0; bar.st = nullptr;
    if (N_LAUNCHES == 1) bar = xcd_barrier_post((unsigned*)(F.ctl + CW_BAR), F.MISC + 8);
    const int lo = args.ph_lo, hi = args.ph_hi;
#define IN(k) (lo <= (k) && (k) < hi)
#define BOTH(k) (IN(k) && IN((k) + 1))
#define GRID_BAR() do { if (N_LAUNCHES == 1) xcd_barrier(bar); } while (0)

    if (IN(0)) { p0_prologue(F); if (BOTH(0)) GRID_BAR(); }

    if (IN(1)) {
        pg8::Gemm g{F.H, F.WT1, M, N1, D}; pg8::StaticOrder S; S.init(M, N1, F.G, (int)blockIdx.x);
        pg8::Epi1 E{F.QKV, F.RW};
        pg8::gemm_phase<pg8::Epi1, pg8::StaticOrder, true, true>(F.lds, g, S, E);
        if (BOTH(1)) GRID_BAR();
    }

    if (IN(2)) {
        att::attn_phase(F);
        rwkv::scan_phase(F);
        if (BOTH(2)) GRID_BAR();
    }

    if (IN(3)) {
        pg8::Gemm g{F.H, F.WT1 + (size_t)N1 * D, M, N2, D}; pg8::StaticOrder S; S.init(M, N2, F.G, (int)blockIdx.x);
        pg8::Epi2 E{F.OA, F.OR, F.A1, F.A2, F.SGA, F.SGB};
        pg8::gemm_phase<pg8::Epi2, pg8::StaticOrder, true, true>(F.lds, g, S, E);
        if (BOTH(3)) GRID_BAR();
    }

    if (IN(4) && F.vcu < M / 256) {
        const pg8::PanelOrder S{F.vcu, 4};
        { pg8::Gemm g{F.A1, F.WTA, M, D, 512}; pg8::EpiMerge<false> E{F.SGA, F.MG};
          pg8::gemm_phase<pg8::EpiMerge<false>, pg8::PanelOrder, true, true>(F.lds, g, S, E); }
        VM_WAIT(); __syncthreads();
        { pg8::Gemm g{F.A2, F.WTB, M, D, 512}; pg8::EpiMerge<true> E{F.SGB, F.MG};
          pg8::gemm_phase<pg8::EpiMerge<true>, pg8::PanelOrder, true, true>(F.lds, g, S, E); }
        VM_WAIT(); __syncthreads();
        if (threadIdx.x == 0) { __builtin_amdgcn_fence(__ATOMIC_ACQUIRE, "agent"); VM_WAIT(); }
        LAS float* ss = (LAS float*)(F.lds + SS_OFF);
        if (threadIdx.x < 256) ss[threadIdx.x] = 0.f;
        __syncthreads();
        { pg8::Gemm g{F.MG, F.WTO, M, D, D}; pg8::EpiOut E{F.out, ss};
          pg8::gemm_phase<pg8::EpiOut, pg8::PanelOrder, true, true>(F.lds, g, S, E); }
        VM_WAIT(); LDS_WAIT(); __syncthreads();
        if (threadIdx.x == 0) { __builtin_amdgcn_fence(__ATOMIC_ACQUIRE, "agent"); VM_WAIT(); }
        __syncthreads();
        int t2 = threadIdx.x; asm volatile("" : "+v"(t2)); const int lane2 = t2 & 63, wave2 = __builtin_amdgcn_readfirstlane(t2 >> 6);
        for (int r = wave2; r < 256; r += NWAVES) { const size_t row = (size_t)F.vcu * 256 + r; const float rstd = 1.0f / sqrtf(ss[r] * (1.0f / D) + RMS_EPS);
            GAS f32x4* op = (GAS f32x4*)(F.out + row * D) + lane2; const GAS f32x4* xp = (const GAS f32x4*)(F.x + row * D) + lane2; const GAS f32x4* gp = (const GAS f32x4*)F.post_g + lane2;
#pragma unroll
            for (int j = 0; j < 4; ++j) { const f32x4 raw = op[64 * j]; op[64 * j] = xp[64 * j] + raw * rstd * gp[64 * j]; } }
    }
#undef IN
#undef BOTH
#undef GRID_BAR
}

extern "C" void kernel_launch(void* const* d_in, const int* in_sizes, int n_in, void* d_out, int out_size, void* d_ws, size_t ws_size, hipStream_t stream) {
    static int grid = 0;
    if (grid == 0) {
        if (n_in != 18 || in_sizes[0] != M * D || out_size != M * D || ws_size < WS_END) { fprintf(stderr, "kernel_launch: unexpected shapes / workspace: n_in %d in0 %d out %d ws %zu (need %zu)\n", n_in, n_in > 0 ? in_sizes[0] : -1, out_size, ws_size, (size_t)WS_END); grid = -1; return; }
        int dev = 0, cus = 0, per_cu = 0;
        if (hipGetDevice(&dev) != hipSuccess || hipDeviceGetAttribute(&cus, hipDeviceAttributeMultiprocessorCount, dev) != hipSuccess) { grid = -1; return; }
        if (hipFuncSetAttribute((const void*)mk_fwd, hipFuncAttributeMaxDynamicSharedMemorySize, LDS_BYTES) != hipSuccess) { fprintf(stderr, "kernel_launch: hipFuncSetAttribute failed\n"); grid = -1; return; }
        if (hipOccupancyMaxActiveBlocksPerMultiprocessor(&per_cu, (const void*)mk_fwd, NWAVES * 64, LDS_BYTES) != hipSuccess || per_cu < 1) fprintf(stderr, "kernel_launch: occupancy query reports %d\n", per_cu);
        (void)hipGetLastError();
        grid = cus;
        if (grid != 256) fprintf(stderr, "kernel_launch: %d CUs (built for 256)\n", grid);
        fprintf(stderr, "kernel_launch: ws_size %zu, grid %d, per_cu %d\n", ws_size, grid, per_cu);
    }
    if (grid < 0) return;
    if (hipMemsetAsync((char*)d_ws + WS_CTL, 0, CTL_ZERO_BYTES, stream) != hipSuccess) return;
    Args a{};
    for (int i = 0; i < 18; ++i) a.in[i] = (const float*)d_in[i];
    a.out = (float*)d_out; a.ws = (unsigned char*)d_ws;
    for (int li = 0; li < N_LAUNCHES; ++li) {
        a.ph_lo = (N_LAUNCHES == 1) ? 0 : li; a.ph_hi = (N_LAUNCHES == 1) ? N_PHASES : li + 1;
        hipLaunchKernelGGL(mk_fwd, dim3(grid), dim3(NWAVES * 64), LDS_BYTES, stream, a);
        if (hipPeekAtLastError() != hipSuccess) { fprintf(stderr, "kernel_launch: launch %d failed\n", li); break; }
    }
}
```

```cpp
#include <hip/hip_runtime.h>
#include <cstdio>
#include <cstdint>
namespace pg8 {
#define PG8_LAS __attribute__((address_space(3)))
typedef unsigned short bf16_t;
typedef short bf16x8 __attribute__((ext_vector_type(8)));
typedef float f32x4 __attribute__((ext_vector_type(4)));
typedef unsigned u32x4 __attribute__((ext_vector_type(4)));
constexpr int BM = 256, BK = 64, HALF = 128, HTB = HALF * BK * 2  , STAGE_BYTES = 8 * HTB, NXCD = 8, WGM = 8;

__host__ __device__ __forceinline__ int lds_byte(int r, int c) { const int st = (r >> 4) * 2 + (c >> 5), rr = r & 15, cc = c & 31, ob = rr * 64 + cc * 2; return st * 1024 + (ob ^ (((ob >> 9) & 1) << 5)); }
__host__ __device__ __forceinline__ void stage_rc(int b, int& R, int& C) { const int st = b / 1024, sb = b % 1024, swz = sb ^ (((sb >> 9) & 1) << 5); R = (st >> 1) * 16 + swz / 64; C = (st & 1) * 32 + (swz % 64) / 2; }
__host__ __device__ __forceinline__ int perm32(int rho) { const int n = rho >> 4, i = rho & 15; return 8 * (i >> 2) + 4 * n + (i & 3); }

struct Unit { int pm, pn; };
struct Gemm { const bf16_t* A; const bf16_t* Bt; int M, N, K; };

struct StaticOrder {
    int nM, nN, nwg, G, c;
    __host__ __device__ void init(int M, int N, int G_, int c_) { nM = M / BM; nN = N / BM; nwg = nM * nN; G = G_; c = c_; }
    __host__ __device__ bool next(int i, Unit& u) const {
        const long L = (long)i * G + c; if (L >= nwg) return false;
        int wgid = (int)L; { const int q = nwg / NXCD, r = nwg % NXCD, xcd = wgid % NXCD, off = wgid / NXCD; wgid = (xcd < r ? xcd * (q + 1) : r * (q + 1) + (xcd - r) * q) + off; }
        const int nig = WGM * nN, gid = wgid / nig, fm = gid * WGM, gsz = (nM - fm) < WGM ? (nM - fm) : WGM;
        u.pm = fm + ((wgid % nig) % gsz); u.pn = (wgid % nig) / gsz; return true;
    }
    __device__ __forceinline__ void a_ready(const Unit&) const {}
    __device__ __forceinline__ void done(const Unit&) const {}
};

__device__ __forceinline__ unsigned cvt_pk_bf16(float lo, float hi) { unsigned r; asm volatile("v_cvt_pk_bf16_f32 %0, %1, %2" : "=v"(r) : "v"(lo), "v"(hi)); return r; }
typedef unsigned u32x4 __attribute__((ext_vector_type(4)));
typedef unsigned u32x2 __attribute__((ext_vector_type(2)));
__device__ __forceinline__ float bf_lo(unsigned w) { return __builtin_bit_cast(float, w << 16); }
__device__ __forceinline__ float bf_hi(unsigned w) { return __builtin_bit_cast(float, w & 0xffff0000u); }
__device__ __forceinline__ float sigmoid_f(float z) { return __builtin_amdgcn_rcpf(1.0f + __builtin_amdgcn_exp2f(-1.4426950408889634f * z)); }
constexpr float QSCALE = 0.125f * 1.4426950408889634f;

struct PanelOrder {
    int pm, nN;
    __device__ __forceinline__ bool next(int i, Unit& u) const { if (i >= nN) return false; u.pm = pm; u.pn = i; return true; }
    __device__ __forceinline__ void a_ready(const Unit&) const {}
    __device__ __forceinline__ void done(const Unit&) const {}
};

struct Epi1 {
    static constexpr bool PERM = true, AFTER_DRAIN = false;
    bf16_t* QKV; bf16_t* RW;
    __device__ __forceinline__ void operator()(const f32x4 (&acc)[2][2][4][2], const Unit& u, int wr, int wc, int fr, int fq) const {
        const int row0 = u.pm * BM + wr * 64 + fr;
        bf16_t* base; int ldc, colt; float sc = 1.f;
        if (u.pn < 18) { base = QKV; ldc = 4608; colt = u.pn * BM; if (u.pn < 6) sc = QSCALE; } else { base = RW; ldc = 1792; colt = (u.pn - 18) * BM; }
        const int col0 = colt + wc * 32 + 8 * fq;
#pragma unroll
        for (int ai = 0; ai < 2; ++ai)
#pragma unroll
            for (int m = 0; m < 4; ++m) { bf16_t* rowp = base + (size_t)(row0 + ai * HALF + m * 16) * ldc + col0;
#pragma unroll
                for (int bj = 0; bj < 2; ++bj) { const f32x4 v0 = acc[ai][bj][m][0] * sc, v1 = acc[ai][bj][m][1] * sc;
                    u32x4 w; w.x = cvt_pk_bf16(v0[0], v0[1]); w.y = cvt_pk_bf16(v0[2], v0[3]); w.z = cvt_pk_bf16(v1[0], v1[1]); w.w = cvt_pk_bf16(v1[2], v1[3]);
                    *(u32x4*)(rowp + bj * HALF) = w; } }
    }
};

struct Epi2 {
    static constexpr bool PERM = true, AFTER_DRAIN = false;
    const bf16_t* OA; const bf16_t* OR; bf16_t* A1; bf16_t* A2; bf16_t* SGA; bf16_t* SGB;
    __device__ __forceinline__ void operator()(const f32x4 (&acc)[2][2][4][2], const Unit& u, int wr, int wc, int fr, int fq) const {
        const int row0 = u.pm * BM + wr * 64 + fr;
        const bf16_t* mul; bf16_t* dst; int ldc, colt;
        if (u.pn < 2) { mul = OA; dst = A1; ldc = 512; colt = u.pn * BM; }
        else if (u.pn < 4) { mul = OR; dst = A2; ldc = 512; colt = (u.pn - 2) * BM; }
        else if (u.pn < 8) { mul = nullptr; dst = SGA; ldc = 1024; colt = (u.pn - 4) * BM; }
        else { mul = nullptr; dst = SGB; ldc = 1024; colt = (u.pn - 8) * BM; }
        const int col0 = colt + wc * 32 + 8 * fq;
#pragma unroll
        for (int ai = 0; ai < 2; ++ai)
#pragma unroll
            for (int m = 0; m < 4; ++m) { const size_t off = (size_t)(row0 + ai * HALF + m * 16) * ldc + col0;
#pragma unroll
                for (int bj = 0; bj < 2; ++bj) { const f32x4 z0 = acc[ai][bj][m][0], z1 = acc[ai][bj][m][1];
                    float f[8];
#pragma unroll
                    for (int e = 0; e < 4; ++e) { f[e] = sigmoid_f(z0[e]); f[4 + e] = sigmoid_f(z1[e]); }
                    if (mul) { const u32x4 o = *(const u32x4*)(mul + off + bj * HALF);
#pragma unroll
                        for (int e = 0; e < 4; ++e) { f[e] *= z0[e]; f[4 + e] *= z1[e]; }
                        f[0] *= bf_lo(o.x); f[1] *= bf_hi(o.x); f[2] *= bf_lo(o.y); f[3] *= bf_hi(o.y); f[4] *= bf_lo(o.z); f[5] *= bf_hi(o.z); f[6] *= bf_lo(o.w); f[7] *= bf_hi(o.w); }
                    u32x4 w; w.x = cvt_pk_bf16(f[0], f[1]); w.y = cvt_pk_bf16(f[2], f[3]); w.z = cvt_pk_bf16(f[4], f[5]); w.w = cvt_pk_bf16(f[6], f[7]);
                    *(u32x4*)(dst + off + bj * HALF) = w; } }
    }
};

template <bool ADD> struct EpiMerge {
    static constexpr bool PERM = true, AFTER_DRAIN = false;
    const bf16_t* SG; bf16_t* MG;
    __device__ __forceinline__ void operator()(const f32x4 (&acc)[2][2][4][2], const Unit& u, int wr, int wc, int fr, int fq) const {
        const int row0 = u.pm * BM + wr * 64 + fr, col0 = u.pn * BM + wc * 32 + 8 * fq;
#pragma unroll
        for (int ai = 0; ai < 2; ++ai)
#pragma unroll
            for (int m = 0; m < 4; ++m) { const size_t off = (size_t)(row0 + ai * HALF + m * 16) * 1024 + col0;
#pragma unroll
                for (int bj = 0; bj < 2; ++bj) { const f32x4 z0 = acc[ai][bj][m][0], z1 = acc[ai][bj][m][1];
                    const u32x4 g = *(const u32x4*)(SG + off + bj * HALF);
                    float f[8];
                    f[0] = z0[0] * bf_lo(g.x); f[1] = z0[1] * bf_hi(g.x); f[2] = z0[2] * bf_lo(g.y); f[3] = z0[3] * bf_hi(g.y);
                    f[4] = z1[0] * bf_lo(g.z); f[5] = z1[1] * bf_hi(g.z); f[6] = z1[2] * bf_lo(g.w); f[7] = z1[3] * bf_hi(g.w);
                    if (ADD) { const u32x4 p = *(const u32x4*)(MG + off + bj * HALF);
                        f[0] += bf_lo(p.x); f[1] += bf_hi(p.x); f[2] += bf_lo(p.y); f[3] += bf_hi(p.y); f[4] += bf_lo(p.z); f[5] += bf_hi(p.z); f[6] += bf_lo(p.w); f[7] += bf_hi(p.w); }
                    u32x4 w; w.x = cvt_pk_bf16(f[0], f[1]); w.y = cvt_pk_bf16(f[2], f[3]); w.z = cvt_pk_bf16(f[4], f[5]); w.w = cvt_pk_bf16(f[6], f[7]);
                    *(u32x4*)(MG + off + bj * HALF) = w; } }
    }
};

struct EpiOut {
    static constexpr bool PERM = true, AFTER_DRAIN = false;
    float* OUT; PG8_LAS float* ss;
    __device__ __forceinline__ void operator()(const f32x4 (&acc)[2][2][4][2], const Unit& u, int wr, int wc, int fr, int fq) const {
        const int row0 = u.pm * BM + wr * 64 + fr, col0 = u.pn * BM + wc * 32 + 8 * fq;
#pragma unroll
        for (int ai = 0; ai < 2; ++ai)
#pragma unroll
            for (int m = 0; m < 4; ++m) { float* rowp = OUT + (size_t)(row0 + ai * HALF + m * 16) * 1024 + col0; float q = 0.f;
#pragma unroll
                for (int bj = 0; bj < 2; ++bj) { const f32x4 z0 = acc[ai][bj][m][0], z1 = acc[ai][bj][m][1];
                    q += (z0[0] * z0[0] + z0[1] * z0[1]) + (z0[2] * z0[2] + z0[3] * z0[3]) + (z1[0] * z1[0] + z1[1] * z1[1]) + (z1[2] * z1[2] + z1[3] * z1[3]);
                    *(f32x4*)(rowp + bj * HALF) = z0; *(f32x4*)(rowp + bj * HALF + 4) = z1; }
                q += __shfl_xor(q, 16); q += __shfl_xor(q, 32);
                if (fq == 0) __hip_atomic_fetch_add(ss + (ai * HALF + wr * 64 + m * 16 + fr), q, __ATOMIC_RELAXED, __HIP_MEMORY_SCOPE_WORKGROUP); }
    }
};

template <class Epi, class Sched, bool ALIGN_EPI = false, bool SP2 = false>
__device__ __forceinline__ void gemm_phase(PG8_LAS unsigned char* lds, const Gemm g, const Sched& S, const Epi& E) {
    const int tid = threadIdx.x, wid = __builtin_amdgcn_readfirstlane(tid >> 6), lane = tid & 63, wr = wid >> 2, wc = wid & 3, fr = lane & 15, fq = lane >> 4;
    const int K = g.K, nt = K / BK;
    unsigned voffA[2], voffB[2];
#pragma unroll
    for (int i = 0; i < 2; ++i) { int R, C; stage_rc(tid * 16 + i * 8192, R, C); const int Rb = Epi::PERM ? ((R & ~31) + perm32(R & 31)) : R;
        voffA[i] = (unsigned)(R * K + C) * 2u; voffB[i] = (unsigned)(Rb * K + C) * 2u; }
    const size_t kstep = (size_t)(BK * 2);
    const size_t hstep = (size_t)HALF * K * 2;
    const size_t tstep = 2 * hstep;
    const unsigned ldsw = (unsigned)wid * 1024u;
    const int aoff = lds_byte(wr * 64 + fr, fq * 8), boff = lds_byte(wc * 32 + fr, fq * 8);
#define PG8_SA(b, h) (((b) * 2 + (h)) * HTB)
#define PG8_SB(b, h) ((4 + (b) * 2 + (h)) * HTB)
#define PG8_STAGE(bufoff, gbase, voff) do { _Pragma("unroll") for (int _i = 0; _i < 2; ++_i) \
        __builtin_amdgcn_global_load_lds((const unsigned*)((const char*)(gbase) + (voff)[_i]), (PG8_LAS unsigned*)(lds + (bufoff) + ldsw + _i * 8192), 16, 0, 0); } while (0)
#define PG8_LDA(dst, b, h) do { _Pragma("unroll") for (int m = 0; m < 4; ++m) _Pragma("unroll") for (int k = 0; k < 2; ++k) dst[m][k] = *(const PG8_LAS bf16x8*)(lds + PG8_SA(b, h) + aoff + m * 2048 + k * 1024); } while (0)
#define PG8_LDB(dst, b, h) do { _Pragma("unroll") for (int n = 0; n < 2; ++n) _Pragma("unroll") for (int k = 0; k < 2; ++k) dst[n][k] = *(const PG8_LAS bf16x8*)(lds + PG8_SB(b, h) + boff + n * 2048 + k * 1024); } while (0)
#define PG8_MMA(ai, bj, At, Bt) do { __builtin_amdgcn_s_setprio(1); _Pragma("unroll") for (int m = 0; m < 4; ++m) _Pragma("unroll") for (int n = 0; n < 2; ++n) _Pragma("unroll") for (int k = 0; k < 2; ++k) \
        acc[ai][bj][m][n] = __builtin_amdgcn_mfma_f32_16x16x32_bf16(Bt[n][k], At[m][k], acc[ai][bj][m][n], 0, 0, 0); __builtin_amdgcn_s_setprio(0); } while (0)
#define PG8_WAIT_V(n) asm volatile("s_waitcnt vmcnt(" #n ")" ::: "memory")
#define PG8_WAIT_L(n) asm volatile("s_waitcnt lgkmcnt(" #n ")" ::: "memory")
#define PG8_BAR __builtin_amdgcn_s_barrier()
#define PG8_SCHED __builtin_amdgcn_sched_barrier(0)
    Unit cur, nxt; int ui = 0;
    if (!S.next(0, cur)) return;
    f32x4 acc[2][2][4][2];
#pragma unroll
    for (int a = 0; a < 2; ++a)
#pragma unroll
        for (int b = 0; b < 2; ++b)
#pragma unroll
            for (int m = 0; m < 4; ++m)
#pragma unroll
                for (int n = 0; n < 2; ++n) acc[a][b][m][n] = (f32x4){0.f, 0.f, 0.f, 0.f};
    bf16x8 At[4][2], B0[2][2], B1[2][2];
    const char* cA = (const char*)g.A + (size_t)cur.pm * tstep; const char* cB = (const char*)g.Bt + (size_t)cur.pn * tstep;
    S.a_ready(cur);
    if constexpr (SP2) {
        PG8_STAGE(PG8_SB(0, 0), cB, voffB); PG8_STAGE(PG8_SB(0, 1), cB + hstep, voffB); PG8_STAGE(PG8_SA(0, 0), cA, voffA); PG8_STAGE(PG8_SA(0, 1), cA + hstep, voffA);
        if (wr == 1) PG8_BAR;
        PG8_WAIT_V(2); PG8_BAR;
        PG8_STAGE(PG8_SB(1, 0), cB + kstep, voffB); PG8_STAGE(PG8_SA(1, 0), cA + kstep, voffA); PG8_STAGE(PG8_SB(1, 1), cB + hstep + kstep, voffB);
        PG8_WAIT_V(6); PG8_BAR;
    } else {
        PG8_STAGE(PG8_SB(0, 0), cB, voffB); PG8_STAGE(PG8_SA(0, 0), cA, voffA); PG8_STAGE(PG8_SB(0, 1), cB + hstep, voffB); PG8_STAGE(PG8_SA(0, 1), cA + hstep, voffA);
        if (wr == 1) PG8_BAR;
        PG8_WAIT_V(4); PG8_BAR;
        PG8_STAGE(PG8_SB(1, 0), cB + kstep, voffB); PG8_STAGE(PG8_SA(1, 0), cA + kstep, voffA); PG8_STAGE(PG8_SB(1, 1), cB + hstep + kstep, voffB);
        PG8_WAIT_V(6); PG8_BAR;
    }
    for (;;) {
        const bool has_next = S.next(ui + 1, nxt);
        const char* nA = has_next ? (const char*)g.A + (size_t)nxt.pm * tstep : cA; const char* nB = has_next ? (const char*)g.Bt + (size_t)nxt.pn * tstep : cB;
        for (int t = 0; t < nt; t += 2) {
            const bool last = (t == nt - 2);
            const char* a1 = cA + (size_t)(t + 1) * kstep;
            const char* a2 = last ? nA : cA + (size_t)(t + 2) * kstep; const char* b2 = last ? nB : cB + (size_t)(t + 2) * kstep;
            const char* a3 = a2 + kstep; const char* b3 = b2 + kstep;
            if (last && has_next) S.a_ready(nxt);
            if constexpr (SP2) {
            PG8_LDB(B0, 0, 0); PG8_LDB(B1, 0, 1); PG8_SCHED; PG8_LDA(At, 0, 0); PG8_STAGE(PG8_SA(1, 1), a1 + hstep, voffA);
            PG8_WAIT_V(8); PG8_WAIT_L(0); PG8_BAR; PG8_MMA(0, 0, At, B0); PG8_MMA(0, 1, At, B1); PG8_BAR; PG8_SCHED;
            PG8_LDA(At, 0, 1); PG8_STAGE(PG8_SB(0, 0), b2, voffB); PG8_STAGE(PG8_SB(0, 1), b2 + hstep, voffB); PG8_STAGE(PG8_SA(0, 0), a2, voffA);
            PG8_WAIT_V(8); PG8_WAIT_L(0); PG8_BAR; PG8_MMA(1, 0, At, B0); PG8_MMA(1, 1, At, B1); PG8_BAR; PG8_SCHED;
            PG8_LDB(B0, 1, 0); PG8_LDB(B1, 1, 1); PG8_SCHED; PG8_LDA(At, 1, 0); PG8_STAGE(PG8_SA(0, 1), a2 + hstep, voffA);
            PG8_WAIT_V(8); PG8_WAIT_L(0); PG8_BAR; PG8_MMA(0, 0, At, B0); PG8_MMA(0, 1, At, B1); PG8_BAR; PG8_SCHED;
            PG8_LDA(At, 1, 1); PG8_STAGE(PG8_SB(1, 0), b3, voffB); PG8_STAGE(PG8_SB(1, 1), b3 + hstep, voffB); PG8_STAGE(PG8_SA(1, 0), a3, voffA);
            PG8_WAIT_V(8); PG8_WAIT_L(0); PG8_BAR; PG8_MMA(1, 0, At, B0); PG8_MMA(1, 1, At, B1); PG8_BAR; PG8_SCHED;
            } else {
            PG8_LDB(B0, 0, 0); PG8_SCHED; PG8_LDA(At, 0, 0); PG8_STAGE(PG8_SA(1, 1), a1 + hstep, voffA);
            PG8_WAIT_L(8); PG8_BAR; PG8_WAIT_L(0); PG8_MMA(0, 0, At, B0); PG8_BAR; PG8_SCHED;
            PG8_LDB(B1, 0, 1); PG8_STAGE(PG8_SB(0, 0), b2, voffB);
            PG8_BAR; PG8_WAIT_L(0); PG8_MMA(0, 1, At, B1); PG8_BAR;
            PG8_LDA(At, 0, 1); PG8_STAGE(PG8_SA(0, 0), a2, voffA);
            PG8_BAR; PG8_WAIT_L(0); PG8_MMA(1, 0, At, B0); PG8_BAR; PG8_SCHED;
            PG8_STAGE(PG8_SB(0, 1), b2 + hstep, voffB);
            PG8_WAIT_V(6); PG8_BAR; PG8_MMA(1, 1, At, B1); PG8_BAR;
            PG8_LDB(B0, 1, 0); PG8_SCHED; PG8_LDA(At, 1, 0); PG8_STAGE(PG8_SA(0, 1), a2 + hstep, voffA);
            PG8_WAIT_L(8); PG8_BAR; PG8_WAIT_L(0); PG8_MMA(0, 0, At, B0); PG8_BAR; PG8_SCHED;
            PG8_LDB(B1, 1, 1); PG8_STAGE(PG8_SB(1, 0), b3, voffB);
            PG8_BAR; PG8_WAIT_L(0); PG8_MMA(0, 1, At, B1); PG8_BAR;
            PG8_LDA(At, 1, 1); PG8_STAGE(PG8_SA(1, 0), a3, voffA);
            PG8_BAR; PG8_WAIT_L(0); PG8_MMA(1, 0, At, B0); PG8_BAR; PG8_SCHED;
            PG8_STAGE(PG8_SB(1, 1), b3 + hstep, voffB);
            PG8_WAIT_V(6); PG8_BAR; PG8_MMA(1, 1, At, B1); PG8_BAR;
            }
        }
        if constexpr (ALIGN_EPI) { if (wr == 0) PG8_BAR; }
        if constexpr (!Epi::AFTER_DRAIN) { E(acc, cur, wr, wc, fr, fq); S.done(cur); }
        if (!has_next) break;
#pragma unroll
        for (int a = 0; a < 2; ++a)
#pragma unroll
            for (int b = 0; b < 2; ++b)
#pragma unroll
                for (int m = 0; m < 4; ++m)
#pragma unroll
                    for (int n = 0; n < 2; ++n) acc[a][b][m][n] = (f32x4){0.f, 0.f, 0.f, 0.f};
        cur = nxt; cA = nA; cB = nB; ++ui;
        if constexpr (ALIGN_EPI) { if (wr == 1) PG8_BAR; }
    }
    PG8_WAIT_V(0);
    if constexpr (!ALIGN_EPI) { if (wr == 0) PG8_BAR; }
    PG8_BAR;
    if constexpr (Epi::AFTER_DRAIN) { E.fused(acc, cur, wr, wc, fr, fq, lds, wid, lane); S.done(cur); }
#undef PG8_SA
#undef PG8_SB
#undef PG8_STAGE
#undef PG8_LDA
#undef PG8_LDB
#undef PG8_MMA
#undef PG8_WAIT_V
#undef PG8_WAIT_L
#undef PG8_BAR
#undef PG8_SCHED
}
}

constexpr int NWAVES = 8;
constexpr int BATCH = 32, SEQ = 2048, D = 1024, M = BATCH * SEQ;
constexpr int NQKV = 4608, RW_LD = 1792, LDW_IN = 9344;
constexpr int N1 = 6400, N2 = 3072, WT1_ROWS = N1 + N2;
constexpr int OFF_ATTN_GATE = 4608, OFF_RWKV = 5120, OFF_RWKV_GATE = 6784, OFF_MERGE = 7296;
constexpr float RMS_EPS = 1e-6f, GN_EPS = 64e-5f;
constexpr float LOG2E = 1.4426950408889634f;

constexpr size_t MiB = 1u << 20;
constexpr size_t WS_CTL = 0, CTL_ZERO_BYTES = 1 * MiB;
constexpr size_t WS_WT1 = 2 * MiB, WS_WTA = 22 * MiB, WS_WTB = 23 * MiB, WS_WTO = 24 * MiB, WS_LSE = 26 * MiB;
constexpr size_t WS_H = 32 * MiB, WS_QKV = 160 * MiB, WS_RW = 736 * MiB, WS_END = 960 * MiB;
constexpr size_t WS_SGA = 160 * MiB, WS_SGB = 288 * MiB, WS_A1 = 416 * MiB, WS_A2 = 480 * MiB, WS_MG = 544 * MiB;
static_assert(WS_WT1 + (size_t)WT1_ROWS * D * 2 <= WS_WTA && WS_LSE + (size_t)3 * M * 8 * 4 <= WS_H && WS_H + (size_t)M * D * 2 <= WS_QKV && WS_QKV + (size_t)M * NQKV * 2 <= WS_RW && WS_RW + (size_t)M * RW_LD * 2 <= WS_END && WS_MG + (size_t)M * D * 2 <= WS_RW, "d_ws map");
constexpr size_t OUT_OA = 0, OUT_OR = 64 * MiB;
constexpr int CW_BAR = 4096;

constexpr int RING_BYTES = 131072;
constexpr int LDS_BYTES = 163840;
constexpr int LDSCTL_OFF = LDS_BYTES - 2048, MISC_OFF = LDSCTL_OFF + 320, SS_OFF = MISC_OFF + 128;
static_assert(SS_OFF + 1024 <= LDS_BYTES, "LDS map");

#define GAS __attribute__((address_space(1)))
#define LAS __attribute__((address_space(3)))
typedef unsigned short bf16;
typedef unsigned v4u __attribute__((ext_vector_type(4)));
typedef unsigned v2u __attribute__((ext_vector_type(2)));
typedef float f32x4 __attribute__((ext_vector_type(4)));
typedef short bf16x8 __attribute__((ext_vector_type(8)));
typedef short s16x4 __attribute__((ext_vector_type(4)));
typedef GAS unsigned gu32;
#define LDS_WAIT() asm volatile("s_waitcnt lgkmcnt(0)" ::: "memory")
#define VM_WAIT() asm volatile("s_waitcnt vmcnt(0)" ::: "memory")
__device__ __forceinline__ unsigned f2bf(float f) { unsigned u = __builtin_bit_cast(unsigned, f); return (u + 0x7fffu + ((u >> 16) & 1u)) >> 16; }
__device__ __forceinline__ unsigned pk2(float lo, float hi) { return f2bf(lo) | (f2bf(hi) << 16); }
__device__ __forceinline__ float bflo(unsigned w) { return __builtin_bit_cast(float, w << 16); }
__device__ __forceinline__ float bfhi(unsigned w) { return __builtin_bit_cast(float, w & 0xffff0000u); }
template <int CTRL> __device__ __forceinline__ float dpp_f(float v) { return __builtin_bit_cast(float, __builtin_amdgcn_update_dpp(0, __builtin_bit_cast(int, v), CTRL, 0xF, 0xF, false)); }
__device__ __forceinline__ float sum4(float v) { v += dpp_f<0xB1>(v); v += dpp_f<0x4E>(v); return v; }
__device__ __forceinline__ float sum8(float v) { v = sum4(v); v += dpp_f<0x141>(v); return v; }
__device__ __forceinline__ float sum16(float v) { v = sum8(v); v += dpp_f<0x140>(v); return v; }
__device__ __forceinline__ float max16(float v) { v = fmaxf(v, dpp_f<0xB1>(v)); v = fmaxf(v, dpp_f<0x4E>(v)); v = fmaxf(v, dpp_f<0x141>(v)); v = fmaxf(v, dpp_f<0x140>(v)); return v; }
__device__ __forceinline__ float sigm(float z) { return __builtin_amdgcn_rcpf(1.0f + __builtin_amdgcn_exp2f(-LOG2E * z)); }
#define XB_TMO      128
#define XB_XCNT(j)  (256  + 64 * (j))
#define XB_XSUB(j)  (1280 + 64 * (j))
#define XB_XGEN(j)  (2304 + 64 * (j))
#define XB_TOP      3328
#define XB_TOPGEN   3392
#define XCD_BAR_WORDS 3456
#define XB_SPIN_CAP (1u << 18)

__device__ __forceinline__ unsigned xb_ld(unsigned* p)              { return __hip_atomic_load(p, __ATOMIC_RELAXED, __HIP_MEMORY_SCOPE_AGENT); }
__device__ __forceinline__ unsigned xb_add(unsigned* p, unsigned v) { return __hip_atomic_fetch_add(p, v, __ATOMIC_RELAXED, __HIP_MEMORY_SCOPE_AGENT); }
__device__ __forceinline__ unsigned xb_xcc_id() { return (unsigned)__builtin_amdgcn_s_getreg((3 << 11) | 20) & 0xFu; }
#define XB_SPIN(cond, bar) do { unsigned _sp = 0; while (cond) { __builtin_amdgcn_s_sleep(1); \
    if ((++_sp & 255u) == 0u) { if (xb_ld(&(bar)[XB_TMO])) break; if (_sp > XB_SPIN_CAP) { atomicAdd(&(bar)[XB_TMO], 1u); break; } } } } while (0)

struct XcdBarrier {
    unsigned* bar; unsigned x;
    volatile LAS unsigned* st;
};

__device__ __forceinline__ XcdBarrier xcd_barrier_post(unsigned* bar, volatile LAS unsigned* st) {
    XcdBarrier b; b.bar = bar; b.x = xb_xcc_id(); b.st = st;
    if (threadIdx.x == 0) (void)xb_add(&bar[XB_XCNT(b.x)], 1u);
    return b;
}
__device__ __forceinline__ void xcd_barrier_complete(unsigned* bar, unsigned x, unsigned& nloc, unsigned& nx) {
    const unsigned G = gridDim.x * gridDim.y * gridDim.z;
    unsigned sum, cnt, mine, sp = 0u;
    for (;;) {
        sum = 0u; cnt = 0u; mine = 0u;
#pragma unroll
        for (unsigned j = 0; j < 16; ++j) { const unsigned c = xb_ld(&bar[XB_XCNT(j)]); sum += c; cnt += (c > 0u) ? 1u : 0u; mine = (j == x) ? c : mine; }
        if (sum == G) break;
        __builtin_amdgcn_s_sleep(1);
        if ((++sp & 255u) == 0u) { if (xb_ld(&bar[XB_TMO])) break; if (sp > XB_SPIN_CAP) { atomicAdd(&bar[XB_TMO], 1u); break; } }
    }
    nloc = mine > 0u ? mine : 1u; nx = cnt > 0u ? cnt : 1u;
}

__device__ __forceinline__ void xcd_barrier(const XcdBarrier& b) {
    asm volatile("s_waitcnt vmcnt(0)" ::: "memory");
    __syncthreads();
    if (threadIdx.x == 0) {
        unsigned* bar = b.bar;
        __builtin_amdgcn_s_waitcnt(0);
        unsigned nloc = b.st[0], nx = b.st[1];
        if (nloc == 0u) { xcd_barrier_complete(bar, b.x, nloc, nx); b.st[0] = nloc; b.st[1] = nx; }
        const unsigned old = xb_add(&bar[XB_XSUB(b.x)], 1u);
        const unsigned gen = old / nloc;
        if (old + 1u == (gen + 1u) * nloc) {
            __builtin_amdgcn_fence(__ATOMIC_RELEASE, "agent");
            asm volatile("s_waitcnt vmcnt(0)" ::: "memory");
            const unsigned og = xb_add(&bar[XB_TOP], 1u);
            const unsigned tg = og / nx;
            if (og + 1u == (tg + 1u) * nx) xb_add(&bar[XB_TOPGEN], 1u);
            else XB_SPIN(xb_ld(&bar[XB_TOPGEN]) == tg, bar);
            __builtin_amdgcn_fence(__ATOMIC_ACQUIRE, "agent");
            xb_add(&bar[XB_XGEN(b.x)], 1u);
            asm volatile("s_waitcnt vmcnt(0)" ::: "memory");
        } else {
            XB_SPIN(xb_ld(&bar[XB_XGEN(b.x)]) == gen, bar);
            __builtin_amdgcn_fence(__ATOMIC_ACQUIRE, "agent");
            asm volatile("s_waitcnt vmcnt(0)" ::: "memory");
        }
    }
    __syncthreads();
}

struct Frame {
    LAS unsigned char* lds;
    volatile LAS unsigned* MISC;
    gu32* ctl;
    int tid, lane, wave;
    int vcu, G;
    const float* x; float* out;
    const float *pre_g, *w_in, *rel_bias, *mix, *w0, *w_up, *a0, *a_up, *k_k, *k_a, *r_k, *ln_w, *ln_b, *w_upA, *w_upB, *w_out, *post_g;
    bf16 *WT1, *WTA, *WTB, *WTO, *H, *QKV, *RW, *SGA, *SGB, *A1, *A2, *MG, *OA, *OR;
    float* LSE;
};

__device__ __forceinline__ float wave_sum(float v) {
#pragma unroll
    for (int o = 1; o < 64; o <<= 1) v += __shfl_xor(v, o);
    return v;
}
__device__ __forceinline__ void p0_transpose_item(const float* W, int K, int ldw, int c0, int nblk, bf16* WT, int row_off, LAS float* scr, int item, int lane) {
    const int kb = item / nblk, nb = item % nblk, k0 = 64 * kb, n0 = 32 * nb;
#pragma unroll 8
    for (int i = 0; i < 32; ++i) { const int kk = 2 * i + (lane >> 5); scr[kk * 33 + (lane & 31)] = W[(size_t)(k0 + kk) * ldw + c0 + n0 + (lane & 31)]; }
    LDS_WAIT(); asm volatile("" ::: "memory");
    const int c = lane & 7;
#pragma unroll
    for (int j = 0; j < 4; ++j) { const int n = (lane >> 3) + 8 * j; const LAS float* s = scr + (8 * c) * 33 + n;
        v4u o; o.x = pk2(s[0 * 33], s[1 * 33]); o.y = pk2(s[2 * 33], s[3 * 33]); o.z = pk2(s[4 * 33], s[5 * 33]); o.w = pk2(s[6 * 33], s[7 * 33]);
        *(GAS v4u*)(WT + (size_t)(row_off + n0 + n) * K + k0 + 8 * c) = o; }
    LDS_WAIT(); asm volatile("" ::: "memory");
}
__device__ __forceinline__ void rms_row_to_bf16(Frame& F, const float* xrow, bf16* orow) {
    const GAS f32x4* xr = (const GAS f32x4*)xrow + F.lane; const GAS f32x4* gr = (const GAS f32x4*)F.pre_g + F.lane;
    f32x4 v[4]; float s = 0.f;
#pragma unroll
    for (int j = 0; j < 4; ++j) { v[j] = xr[64 * j]; s += (v[j].x * v[j].x + v[j].y * v[j].y) + (v[j].z * v[j].z + v[j].w * v[j].w); }
    const float rstd = 1.f / sqrtf(wave_sum(s) * (1.f / D) + RMS_EPS);
    GAS unsigned long long* o8 = (GAS unsigned long long*)orow + F.lane;
#pragma unroll
    for (int j = 0; j < 4; ++j) { const f32x4 g = gr[64 * j]; const f32x4 y = v[j] * rstd * g;
        o8[64 * j] = (unsigned long long)pk2(y.x, y.y) | ((unsigned long long)pk2(y.z, y.w) << 32); }
}
__device__ __forceinline__ void p0_prologue(Frame& F) {
    LAS float* scr = (LAS float*)(F.lds + F.wave * 16384);
    const int gw = F.vcu * NWAVES + F.wave, NGW = F.G * NWAVES;
    constexpr int I1 = 16 * 144, I2 = 16 * 52, I4 = 16 * 16, I5 = 16 * 16, I6 = 16 * 64, I7 = 8 * 32, I8 = 8 * 32, I9 = 16 * 32;
    constexpr int NITEMS = I1 + I2 + I4 + I5 + I6 + I7 + I8 + I9;
    for (int it = gw; it < NITEMS; it += NGW) {
        int r = it;
        if (r < I1) { p0_transpose_item(F.w_in, D, LDW_IN, 0, 144, F.WT1, 0, scr, r, F.lane); continue; } r -= I1;
        if (r < I2) { p0_transpose_item(F.w_in, D, LDW_IN, OFF_RWKV, 52, F.WT1, 4608, scr, r, F.lane); continue; } r -= I2;
        if (r < I4) { p0_transpose_item(F.w_in, D, LDW_IN, OFF_ATTN_GATE, 16, F.WT1, N1, scr, r, F.lane); continue; } r -= I4;
        if (r < I5) { p0_transpose_item(F.w_in, D, LDW_IN, OFF_RWKV_GATE, 16, F.WT1, N1 + 512, scr, r, F.lane); continue; } r -= I5;
        if (r < I6) { p0_transpose_item(F.w_in, D, LDW_IN, OFF_MERGE, 64, F.WT1, N1 + 1024, scr, r, F.lane); continue; } r -= I6;
        if (r < I7) { p0_transpose_item(F.w_upA, 512, D, 0, 32, F.WTA, 0, scr, r, F.lane); continue; } r -= I7;
        if (r < I8) { p0_transpose_item(F.w_upB, 512, D, 0, 32, F.WTB, 0, scr, r, F.lane); continue; } r -= I8;
        p0_transpose_item(F.w_out, D, D, 0, 32, F.WTO, 0, scr, r, F.lane);
    }
    { const int gt = F.vcu * (NWAVES * 64) + F.tid, NT = F.G * NWAVES * 64;
      for (int i = gt; i < 16384; i += NT) *((GAS v4u*)(F.WT1 + (size_t)6272 * D) + i) = (v4u){0u, 0u, 0u, 0u}; }
    for (int m = gw; m < M; m += NGW) rms_row_to_bf16(F, F.x + (size_t)m * D, F.H + (size_t)m * D);
}

namespace att {
constexpr int KSTR = 144;
constexpr int KS_OFF = 0, VS_OFF = 272 * KSTR, PS_OFF = 2 * 272 * KSTR, PSTR = 336, PS_WAVE = 16 * PSTR, BIAS_OFF = PS_OFF + 8 * PS_WAVE, END_OFF = BIAS_OFF + 544;
static_assert(END_OFF <= RING_BYTES, "attention LDS");
typedef short v4i16_t __attribute__((ext_vector_type(4)));
__device__ __forceinline__ s16x4 vtr(LAS const unsigned char* p) { return __builtin_bit_cast(s16x4, __builtin_amdgcn_ds_read_tr16_b64_v4i16((LAS v4i16_t*)p)); }
__device__ __forceinline__ int t5_bucket(int d) {
    if (d < 16) return d;
    int b = 16;
    b += (d >= 22); b += (d >= 30); b += (d >= 40); b += (d >= 54); b += (d >= 73); b += (d >= 99); b += (d >= 134); b += (d >= 182);
    b += (d >= 246); b += (d >= 332); b += (d >= 450); b += (d >= 609); b += (d >= 825); b += (d >= 1117); b += (d >= 1513);
    return b;
}

__device__ __forceinline__ void attn_phase(Frame& F) {
    LAS unsigned char* lds = F.lds;
    const int tid = F.tid, lane = F.lane, w = F.wave, c = lane & 15, q = lane >> 4;
    const int b = F.vcu >> 3, h = F.vcu & 7;
    if (F.vcu >= BATCH * 8) return;
    for (int i = tid; i < 2 * 16 * (KSTR / 4); i += NWAVES * 64) { const int which = i / (16 * (KSTR / 4)), o = i % (16 * (KSTR / 4)); *(LAS unsigned*)(lds + (which ? VS_OFF : KS_OFF) + 256 * KSTR + o * 4) = 0u; }
    LAS float* bias2 = (LAS float*)(lds + BIAS_OFF);
    LAS unsigned char* PSw = lds + PS_OFF + w * PS_WAVE;
    const float NEG_INF = -__builtin_inff();
    for (int g = 0; g < 3; ++g) {
        const int dil = (g == 0) ? 1 : (g == 1) ? 4 : 16, nb = (SEQ / dil) / 128;
        __syncthreads();
        if (tid <= 128) bias2[tid] = F.rel_bias[t5_bucket(tid * dil) * 24 + g * 8 + h] * LOG2E;
        __syncthreads();
        float bl[10][4];
#pragma unroll
        for (int n16 = 0; n16 < 10; ++n16)
#pragma unroll
            for (int reg = 0; reg < 4; ++reg) { const int rel = 128 + 4 * q + reg - 16 * n16 - c; const int rc = rel < 0 ? 0 : (rel > 128 ? 128 : rel);
                const float bv = bias2[rc]; bl[n16][reg] = (rel >= 0 && rel <= 128) ? bv : NEG_INF; }
        const bf16* Qg = F.QKV + (size_t)b * SEQ * NQKV + g * 512 + h * 64;
        float* LSEg = F.LSE + ((size_t)g * M + (size_t)b * SEQ) * 8 + h;
        for (int r = 0; r < dil; ++r)
            for (int n = 0; n < nb; ++n) {
                v4u kreg[4], vreg[4];
#pragma unroll
                for (int it = 0; it < 4; ++it) { const int idx = tid + 512 * it, row = idx >> 3, ch = idx & 7, j = (n - 1) * 128 + row;
                    kreg[it] = (v4u){0u, 0u, 0u, 0u}; vreg[it] = (v4u){0u, 0u, 0u, 0u};
                    if (j >= 0) { const bf16* p = Qg + (size_t)(j * dil + r) * NQKV + ch * 8; kreg[it] = *(const GAS v4u*)(p + 1536); vreg[it] = *(const GAS v4u*)(p + 3072); } }
                bf16x8 aq[2];
                { const bf16* qp = Qg + (size_t)((n * 128 + 16 * w + c) * dil + r) * NQKV + 8 * q;
                  aq[0] = *(const GAS bf16x8*)(qp); aq[1] = *(const GAS bf16x8*)(qp + 32); }
#pragma unroll
                for (int it = 0; it < 4; ++it) { const int idx = tid + 512 * it, row = idx >> 3, ch = idx & 7;
                    *(LAS v4u*)(lds + KS_OFF + row * KSTR + ch * 16) = kreg[it]; *(LAS v4u*)(lds + VS_OFF + row * KSTR + ch * 16) = vreg[it]; }
                __syncthreads();
                f32x4 s[10];
#pragma unroll
                for (int n16 = 0; n16 < 10; ++n16) { s[n16] = (f32x4){0.f, 0.f, 0.f, 0.f};
#pragma unroll
                    for (int ks = 0; ks < 2; ++ks) { const bf16x8 bk = *(const LAS bf16x8*)(lds + KS_OFF + (16 * w + 16 * n16 + c) * KSTR + (32 * ks + 8 * q) * 2);
                        s[n16] = __builtin_amdgcn_mfma_f32_16x16x32_bf16(aq[ks], bk, s[n16], 0, 0, 0); } }
                float mx[4] = {NEG_INF, NEG_INF, NEG_INF, NEG_INF};
#pragma unroll
                for (int n16 = 0; n16 < 10; ++n16) { const bool ok = (n > 0) || (16 * w + 16 * n16 + c >= 128);
#pragma unroll
                    for (int reg = 0; reg < 4; ++reg) { const float v = ok ? s[n16][reg] + bl[n16][reg] : NEG_INF; s[n16][reg] = v; mx[reg] = fmaxf(mx[reg], v); } }
#pragma unroll
                for (int reg = 0; reg < 4; ++reg) mx[reg] = max16(mx[reg]);
                float ls[4] = {0.f, 0.f, 0.f, 0.f};
#pragma unroll
                for (int n16 = 0; n16 < 10; ++n16)
#pragma unroll
                    for (int reg = 0; reg < 4; ++reg) { const float p = __builtin_amdgcn_exp2f(s[n16][reg] - mx[reg]); ls[reg] += p;
                        *(LAS unsigned short*)(PSw + (4 * q + reg) * PSTR + (16 * n16 + c) * 2) = (unsigned short)f2bf(p); }
#pragma unroll
                for (int reg = 0; reg < 4; ++reg) ls[reg] = sum16(ls[reg]);
                f32x4 o[4];
#pragma unroll
                for (int nd = 0; nd < 4; ++nd) o[nd] = (f32x4){0.f, 0.f, 0.f, 0.f};
#pragma unroll
                for (int ks = 0; ks < 5; ++ks) { const bf16x8 pa = *(const LAS bf16x8*)(PSw + c * PSTR + (32 * ks + 8 * q) * 2);
                    LAS const unsigned char* vb = lds + VS_OFF + (16 * w + 32 * ks + 8 * q + (c >> 2)) * KSTR + (c & 3) * 8;
#pragma unroll
                    for (int nd = 0; nd < 4; ++nd) { const s16x4 lo = vtr(vb + nd * 32), hi = vtr(vb + nd * 32 + 4 * KSTR);
                        const bf16x8 bv = (bf16x8){lo[0], lo[1], lo[2], lo[3], hi[0], hi[1], hi[2], hi[3]};
                        o[nd] = __builtin_amdgcn_mfma_f32_16x16x32_bf16(pa, bv, o[nd], 0, 0, 0); } }
                float inv[4];
#pragma unroll
                for (int reg = 0; reg < 4; ++reg) inv[reg] = __builtin_amdgcn_rcpf(ls[reg]);
#pragma unroll
                for (int nd = 0; nd < 4; ++nd)
#pragma unroll
                    for (int reg = 0; reg < 4; ++reg) *(LAS unsigned short*)(PSw + (4 * q + reg) * KSTR + (16 * nd + c) * 2) = (unsigned short)f2bf(o[nd][reg] * inv[reg]);
#pragma unroll
                for (int it = 0; it < 2; ++it) { const int id = lane + 64 * it, row = id >> 3, ch = id & 7;
                    const v4u val = *(const LAS v4u*)(PSw + row * KSTR + ch * 16);
                    *(GAS v4u*)(Qg + (size_t)((n * 128 + 16 * w + row) * dil + r) * NQKV + ch * 8) = val; }
                if (c == 0) {
#pragma unroll
                    for (int reg = 0; reg < 4; ++reg) LSEg[(size_t)((n * 128 + 16 * w + 4 * q + reg) * dil + r) * 8] = mx[reg] + __builtin_amdgcn_logf(ls[reg]);
                }
                __syncthreads();
            }
    }
    VM_WAIT(); __syncthreads();
    if (tid == 0) { __builtin_amdgcn_fence(__ATOMIC_ACQUIRE, "agent"); VM_WAIT(); }
    __syncthreads();
    for (int p = tid; p < SEQ * 8; p += NWAVES * 64) { const int t = p >> 3, ch = p & 7; const size_t row = (size_t)b * SEQ + t;
        float l0 = F.LSE[((size_t)0 * M + row) * 8 + h], l1 = F.LSE[((size_t)1 * M + row) * 8 + h], l2 = F.LSE[((size_t)2 * M + row) * 8 + h];
        const float mm = fmaxf(l0, fmaxf(l1, l2)); float w0 = __builtin_amdgcn_exp2f(l0 - mm), w1 = __builtin_amdgcn_exp2f(l1 - mm), w2 = __builtin_amdgcn_exp2f(l2 - mm);
        const float wi = __builtin_amdgcn_rcpf(w0 + w1 + w2); w0 *= wi; w1 *= wi; w2 *= wi;
        const bf16* qp = F.QKV + row * NQKV + h * 64 + ch * 8;
        const v4u a = *(const GAS v4u*)(qp), bb = *(const GAS v4u*)(qp + 512), cc = *(const GAS v4u*)(qp + 1024);
        v4u o;
        o.x = pk2(w0 * bflo(a.x) + w1 * bflo(bb.x) + w2 * bflo(cc.x), w0 * bfhi(a.x) + w1 * bfhi(bb.x) + w2 * bfhi(cc.x));
        o.y = pk2(w0 * bflo(a.y) + w1 * bflo(bb.y) + w2 * bflo(cc.y), w0 * bfhi(a.y) + w1 * bfhi(bb.y) + w2 * bfhi(cc.y));
        o.z = pk2(w0 * bflo(a.z) + w1 * bflo(bb.z) + w2 * bflo(cc.z), w0 * bfhi(a.z) + w1 * bfhi(bb.z) + w2 * bfhi(cc.z));
        o.w = pk2(w0 * bflo(a.w) + w1 * bflo(bb.w) + w2 * bflo(cc.w), w0 * bfhi(a.w) + w1 * bfhi(bb.w) + w2 * bfhi(cc.w));
        *(GAS v4u*)(F.OA + row * 512 + h * 64 + ch * 8) = o; }
    __syncthreads();
}
}

namespace rwkv {
constexpr int TC = 64, RSTR = 144;
constexpr int WUPT_OFF = 0, AUPT_OFF = 9216, TW_OFF = 18432, AL_OFF = 27648, RAWF_OFF = 36864, Y_OFF = RAWF_OFF;
constexpr int AT_OFF = 86016, RT_OFF = 95232, BT_OFF = 104448, KT_OFF = 113664, VV_OFF = 122880;
constexpr int MK_OFF = 132096, PB_OFF = 134144, PK_OFF = 136192, TT_OFF = 138240, GAM_OFF = 140288, XS_OFF = 141312, SSQ_OFF = 145408, BON_OFF = 145664, END_OFF = 145920;
static_assert(END_OFF <= LDSCTL_OFF, "scan LDS");
typedef short v4i16_t __attribute__((ext_vector_type(4)));
typedef float f32x2_t __attribute__((ext_vector_type(2)));
typedef __bf16 bf16x2_t __attribute__((ext_vector_type(2)));
__device__ __forceinline__ s16x4 vtr(LAS const unsigned char* p) { return __builtin_bit_cast(s16x4, __builtin_amdgcn_ds_read_tr16_b64_v4i16((LAS v4i16_t*)p)); }
__device__ __forceinline__ unsigned cvt2(float lo, float hi) { f32x2_t v = {lo, hi}; bf16x2_t b = __builtin_convertvector(v, bf16x2_t); return __builtin_bit_cast(unsigned, b); }
__device__ __forceinline__ s16x4 pack4(const f32x4& x) { v2u p; p.x = cvt2(x[0], x[1]); p.y = cvt2(x[2], x[3]); return __builtin_bit_cast(s16x4, p); }
#define MFMA16(a, b, c) __builtin_amdgcn_mfma_f32_16x16x16bf16_1k((a), (b), (c), 0, 0, 0)
#define MFMA32(a, b, c) __builtin_amdgcn_mfma_f32_16x16x32_bf16((a), (b), (c), 0, 0, 0)

__device__ __forceinline__ void scan_phase(Frame& F) {
    LAS unsigned char* lds = F.lds;
    const int tid = F.tid, lane = F.lane, w = F.wave, c = lane & 15, q = lane >> 4;
    const int b = F.vcu >> 3, h = F.vcu & 7;
    if (F.vcu >= BATCH * 8) return;
    __syncthreads();
    for (int e = tid; e < 64 * 64; e += NWAVES * 64) { const int j = e >> 6, i = e & 63;
        *(LAS unsigned short*)(lds + WUPT_OFF + i * RSTR + j * 2) = (unsigned short)f2bf(F.w_up[j * 512 + h * 64 + i]);
        *(LAS unsigned short*)(lds + AUPT_OFF + i * RSTR + j * 2) = (unsigned short)f2bf(F.a_up[j * 512 + h * 64 + i]); }
    LAS float* RAWF = (LAS float*)(lds + RAWF_OFF);
    LAS float* Y = (LAS float*)(lds + Y_OFF);
    LAS float* GAM = (LAS float*)(lds + GAM_OFF);
    LAS float* SSQ = (LAS float*)(lds + SSQ_OFF);
    LAS float* BON = (LAS float*)(lds + BON_OFF);
    if (tid < 64) SSQ[tid] = 0.f;
    const bf16* RWb = F.RW + (size_t)b * SEQ * RW_LD;
    v4u cur[5], prv[5];
#define PIECE(it) const int p_ = tid + 512 * (it), tok_ = p_ / 40, rem_ = p_ % 40, run_ = rem_ >> 3, pc_ = rem_ & 7, col_ = (run_ < 3 ? run_ * 512 + h * 64 : (run_ == 3 ? 1536 : 1600)) + pc_ * 8
#define RW_LOAD(t0) do { _Pragma("unroll") for (int it = 0; it < 5; ++it) { PIECE(it); const int t = (t0) + tok_; cur[it] = *(const GAS v4u*)(RWb + (size_t)t * RW_LD + col_); \
        prv[it] = (v4u){0u, 0u, 0u, 0u}; if (t > 0) prv[it] = *(const GAS v4u*)(RWb + (size_t)(t - 1) * RW_LD + col_); } } while (0)
    RW_LOAD(0);
    const int nt = w & 3, ich = 16 * nt + c, hc_e = h * 64 + ich;
    const float p_w0 = F.w0[hc_e], p_a0 = F.a0[hc_e], p_kk = F.k_k[hc_e], p_ka = F.k_a[hc_e], p_rk = F.r_k[hc_e];
    const int otok = tid >> 3, opart = tid & 7, hc_o = h * 64 + 8 * opart;
    f32x4 ST[4];
#pragma unroll
    for (int n = 0; n < 4; ++n) ST[n] = (f32x4){0.f, 0.f, 0.f, 0.f};
    __syncthreads();
    for (int t0 = 0; t0 < SEQ; t0 += TC) {
        if (tid < 64) BON[tid] = 0.f;
#pragma unroll
        for (int it = 0; it < 5; ++it) { PIECE(it);
            const f32x4 m0 = *(const GAS f32x4*)(F.mix + col_), m1 = *(const GAS f32x4*)(F.mix + col_ + 4);
            float x[8];
            { const v4u cu = cur[it], pr = prv[it];
              const float cv[8] = {bflo(cu.x), bfhi(cu.x), bflo(cu.y), bfhi(cu.y), bflo(cu.z), bfhi(cu.z), bflo(cu.w), bfhi(cu.w)};
              const float pv[8] = {bflo(pr.x), bfhi(pr.x), bflo(pr.y), bfhi(pr.y), bflo(pr.z), bfhi(pr.z), bflo(pr.w), bfhi(pr.w)};
              const float mv[8] = {m0[0], m0[1], m0[2], m0[3], m1[0], m1[1], m1[2], m1[3]};
#pragma unroll
              for (int e = 0; e < 8; ++e) x[e] = cv[e] + (pv[e] - cv[e]) * mv[e]; }
            if (run_ < 3) { LAS float* d = RAWF + (tok_ * 3 + run_) * 64 + pc_ * 8;
                *(LAS f32x4*)d = (f32x4){x[0], x[1], x[2], x[3]}; *(LAS f32x4*)(d + 4) = (f32x4){x[4], x[5], x[6], x[7]};
                if (run_ == 1) { const f32x4 k0 = *(const GAS f32x4*)(F.k_k + h * 64 + pc_ * 8), k1 = *(const GAS f32x4*)(F.k_k + h * 64 + pc_ * 8 + 4);
                    float s = 0.f;
#pragma unroll
                    for (int e = 0; e < 4; ++e) { const float z0 = x[e] * k0[e], z1 = x[4 + e] * k1[e]; s += z0 * z0 + z1 * z1; }
                    __hip_atomic_fetch_add(SSQ + tok_, s, __ATOMIC_RELAXED, __HIP_MEMORY_SCOPE_WORKGROUP); } }
            else { if (run_ == 3) {
#pragma unroll
                    for (int e = 0; e < 8; ++e) { const float ex = __builtin_amdgcn_exp2f(2.0f * LOG2E * x[e]); x[e] = 1.0f - 2.0f * __builtin_amdgcn_rcpf(ex + 1.0f); } }
                v4u o; o.x = pk2(x[0], x[1]); o.y = pk2(x[2], x[3]); o.z = pk2(x[4], x[5]); o.w = pk2(x[6], x[7]);
                *(LAS v4u*)(lds + (run_ == 3 ? TW_OFF : AL_OFF) + tok_ * RSTR + pc_ * 16) = o; }
        }
        __syncthreads();
        if (t0 + TC < SEQ) RW_LOAD(t0 + TC);
#pragma unroll
        for (int half = 0; half < 2; ++half) { const int mt = 2 * (w >> 2) + half;
            f32x4 cw = (f32x4){0.f, 0.f, 0.f, 0.f}, ca = (f32x4){0.f, 0.f, 0.f, 0.f};
#pragma unroll
            for (int ks = 0; ks < 2; ++ks) {
                const bf16x8 atw = *(const LAS bf16x8*)(lds + TW_OFF + (16 * mt + c) * RSTR + (32 * ks + 8 * q) * 2), aal = *(const LAS bf16x8*)(lds + AL_OFF + (16 * mt + c) * RSTR + (32 * ks + 8 * q) * 2);
                const bf16x8 bw = *(const LAS bf16x8*)(lds + WUPT_OFF + (16 * nt + c) * RSTR + (32 * ks + 8 * q) * 2), ba = *(const LAS bf16x8*)(lds + AUPT_OFF + (16 * nt + c) * RSTR + (32 * ks + 8 * q) * 2);
                cw = MFMA32(atw, bw, cw); ca = MFMA32(aal, ba, ca); }
            float lw[4], av[4], bv[4], kv[4], rv[4], vv[4];
#pragma unroll
            for (int reg = 0; reg < 4; ++reg) { const int tok = 16 * mt + 4 * q + reg;
                const float sg = sigm(p_w0 + cw[reg]); lw[reg] = -0.6065306597126334f * LOG2E * sg;
                const float al = sigm(p_a0 + ca[reg]);
                const float rr = RAWF[(tok * 3 + 0) * 64 + ich], kr = RAWF[(tok * 3 + 1) * 64 + ich]; vv[reg] = RAWF[(tok * 3 + 2) * 64 + ich];
                const float kkn = kr * p_kk / fmaxf(sqrtf(SSQ[tok]), 1e-12f);
                const float kp = kr * (1.0f + (al - 1.0f) * p_ka);
                av[reg] = -kkn; bv[reg] = kkn * al; kv[reg] = kp; rv[reg] = rr;
                const float bs = sum16(rr * kp * p_rk); if (c == 0) __hip_atomic_fetch_add(BON + tok, bs, __ATOMIC_RELAXED, __HIP_MEMORY_SCOPE_WORKGROUP); }
            float L[4]; L[0] = lw[0]; L[1] = L[0] + lw[1]; L[2] = L[1] + lw[2]; L[3] = L[2] + lw[3];
            float pq = L[3]; { const float t1 = __shfl_up(pq, 16); if (q >= 1) pq += t1; const float t2 = __shfl_up(pq, 32); if (q >= 2) pq += t2; }
            const float excl = pq - L[3];
#pragma unroll
            for (int reg = 0; reg < 4; ++reg) { const int tok = 16 * mt + 4 * q + reg; const float Li = excl + L[reg], Lm = Li - lw[reg];
                const float eP = __builtin_amdgcn_exp2f(Li), eM = __builtin_amdgcn_exp2f(Lm), eN = __builtin_amdgcn_exp2f(-Li);
                const int off = tok * RSTR + ich * 2;
                *(LAS unsigned short*)(lds + AT_OFF + off) = (unsigned short)f2bf(av[reg] * eM);
                *(LAS unsigned short*)(lds + RT_OFF + off) = (unsigned short)f2bf(rv[reg] * eP);
                *(LAS unsigned short*)(lds + BT_OFF + off) = (unsigned short)f2bf(bv[reg] * eN);
                *(LAS unsigned short*)(lds + KT_OFF + off) = (unsigned short)f2bf(kv[reg] * eN);
                *(LAS unsigned short*)(lds + VV_OFF + off) = (unsigned short)f2bf(vv[reg]);
                if (q == 3 && reg == 3) GAM[mt * 64 + ich] = eP; }
        }
        __syncthreads();
        { const int ch = w & 3, tk0 = 16 * ch;
          const bf16x8 aA0 = *(const LAS bf16x8*)(lds + AT_OFF + (tk0 + c) * RSTR + (8 * q) * 2), aA1 = *(const LAS bf16x8*)(lds + AT_OFF + (tk0 + c) * RSTR + (32 + 8 * q) * 2);
          const f32x4 zero4 = (f32x4){0.f, 0.f, 0.f, 0.f};
          if (w < 4) {
              const bf16x8 bB0 = *(const LAS bf16x8*)(lds + BT_OFF + (tk0 + c) * RSTR + (8 * q) * 2), bB1 = *(const LAS bf16x8*)(lds + BT_OFF + (tk0 + c) * RSTR + (32 + 8 * q) * 2);
              f32x4 X = MFMA32(aA0, bB0, zero4); X = MFMA32(aA1, bB1, X);
              LAS unsigned char* xs = lds + XS_OFF + w * 512;
#pragma unroll
              for (int reg = 0; reg < 4; ++reg) *(LAS unsigned short*)(xs + (4 * q + reg) * 32 + c * 2) = (unsigned short)f2bf((c < 4 * q + reg) ? X[reg] : 0.f);
              const s16x4 aX = *(const LAS s16x4*)(xs + c * 32 + 8 * q);
              f32x4 I4;
#pragma unroll
              for (int reg = 0; reg < 4; ++reg) I4[reg] = (4 * q + reg == c) ? 1.f : 0.f;
              f32x4 Tt = I4;
#pragma unroll
              for (int it = 0; it < 15; ++it) Tt = MFMA16(aX, pack4(Tt), I4);
#pragma unroll
              for (int reg = 0; reg < 4; ++reg) *(LAS unsigned short*)(lds + TT_OFF + ch * 512 + (4 * q + reg) * 32 + c * 2) = (unsigned short)f2bf(Tt[reg]);
          } else {
              const bf16x8 aR0 = *(const LAS bf16x8*)(lds + RT_OFF + (tk0 + c) * RSTR + (8 * q) * 2), aR1 = *(const LAS bf16x8*)(lds + RT_OFF + (tk0 + c) * RSTR + (32 + 8 * q) * 2);
              const bf16x8 bB0 = *(const LAS bf16x8*)(lds + BT_OFF + (tk0 + c) * RSTR + (8 * q) * 2), bB1 = *(const LAS bf16x8*)(lds + BT_OFF + (tk0 + c) * RSTR + (32 + 8 * q) * 2);
              const bf16x8 bK0 = *(const LAS bf16x8*)(lds + KT_OFF + (tk0 + c) * RSTR + (8 * q) * 2), bK1 = *(const LAS bf16x8*)(lds + KT_OFF + (tk0 + c) * RSTR + (32 + 8 * q) * 2);
              f32x4 mk = MFMA32(aA0, bK0, zero4); mk = MFMA32(aA1, bK1, mk);
              f32x4 pb = MFMA32(aR0, bB0, zero4); pb = MFMA32(aR1, bB1, pb);
              f32x4 pk = MFMA32(aR0, bK0, zero4); pk = MFMA32(aR1, bK1, pk);
#pragma unroll
              for (int reg = 0; reg < 4; ++reg) { const int o = ch * 512 + (4 * q + reg) * 32 + c * 2; const bool lt = c < 4 * q + reg, le = c <= 4 * q + reg;
                  *(LAS unsigned short*)(lds + MK_OFF + o) = (unsigned short)f2bf(lt ? mk[reg] : 0.f);
                  *(LAS unsigned short*)(lds + PB_OFF + o) = (unsigned short)f2bf(le ? pb[reg] : 0.f);
                  *(LAS unsigned short*)(lds + PK_OFF + o) = (unsigned short)f2bf(le ? pk[reg] : 0.f); }
              if (w == 7) SSQ[lane] = 0.f;
          } }
        __syncthreads();
        if (w < 4) {
#pragma unroll 1
            for (int ch = 0; ch < 4; ++ch) { const int tk0 = 16 * ch;
                const int trow = (tk0 + 4 * q + (c >> 2)) * RSTR + (c & 3) * 8;
                s16x4 sb[4];
#pragma unroll
                for (int n = 0; n < 4; ++n) sb[n] = pack4(ST[n]);
                const s16x4 bV = vtr(lds + VV_OFF + trow + 32 * w);
                f32x4 WT = (f32x4){0.f, 0.f, 0.f, 0.f}, YT = (f32x4){0.f, 0.f, 0.f, 0.f};
#pragma unroll
                for (int n = 0; n < 4; ++n) { const s16x4 aA = *(const LAS s16x4*)(lds + AT_OFF + (tk0 + c) * RSTR + (16 * n + 4 * q) * 2), aR = *(const LAS s16x4*)(lds + RT_OFF + (tk0 + c) * RSTR + (16 * n + 4 * q) * 2);
                    WT = MFMA16(aA, sb[n], WT); YT = MFMA16(aR, sb[n], YT); }
                { const s16x4 aM = *(const LAS s16x4*)(lds + MK_OFF + ch * 512 + c * 32 + 8 * q), aPk = *(const LAS s16x4*)(lds + PK_OFF + ch * 512 + c * 32 + 8 * q);
                  WT = MFMA16(aM, bV, WT); YT = MFMA16(aPk, bV, YT); }
                const s16x4 aT = *(const LAS s16x4*)(lds + TT_OFF + ch * 512 + c * 32 + 8 * q);
                const f32x4 UT = MFMA16(aT, pack4(WT), ((f32x4){0.f, 0.f, 0.f, 0.f}));
                const s16x4 ub = pack4(UT);
                { const s16x4 aPb = *(const LAS s16x4*)(lds + PB_OFF + ch * 512 + c * 32 + 8 * q); YT = MFMA16(aPb, ub, YT); }
#pragma unroll
                for (int reg = 0; reg < 4; ++reg) Y[(tk0 + 4 * q + reg) * 64 + 16 * w + c] = YT[reg];
#pragma unroll
                for (int n = 0; n < 4; ++n) { const s16x4 aB = vtr(lds + BT_OFF + trow + 32 * n), aK = vtr(lds + KT_OFF + trow + 32 * n);
                    ST[n] = MFMA16(aB, ub, ST[n]); ST[n] = MFMA16(aK, bV, ST[n]);
                    const f32x4 gm = *(const LAS f32x4*)(GAM + ch * 64 + 16 * n + 4 * q); ST[n] = ST[n] * gm; }
            }
        }
        __syncthreads();
        { const f32x4 y0 = *(const LAS f32x4*)(Y + otok * 64 + 8 * opart), y1 = *(const LAS f32x4*)(Y + otok * 64 + 8 * opart + 4);
          const float mu = sum8(((y0[0] + y0[1]) + (y0[2] + y0[3])) + ((y1[0] + y1[1]) + (y1[2] + y1[3]))) * (1.0f / 64.0f); const f32x4 d0 = y0 - mu, d1 = y1 - mu;
          const float var = sum8(((d0[0] * d0[0] + d0[1] * d0[1]) + (d0[2] * d0[2] + d0[3] * d0[3])) + ((d1[0] * d1[0] + d1[1] * d1[1]) + (d1[2] * d1[2] + d1[3] * d1[3]))) * (1.0f / 64.0f);
          const float rs = 1.0f / sqrtf(var + GN_EPS); const float bon = BON[otok];
          const v4u vb = *(const LAS v4u*)(lds + VV_OFF + otok * RSTR + opart * 16);
          const f32x4 v0 = (f32x4){bflo(vb.x), bfhi(vb.x), bflo(vb.y), bfhi(vb.y)}, v1 = (f32x4){bflo(vb.z), bfhi(vb.z), bflo(vb.w), bfhi(vb.w)};
          const f32x4 lw0 = *(const GAS f32x4*)(F.ln_w + hc_o), lw1 = *(const GAS f32x4*)(F.ln_w + hc_o + 4), lb0 = *(const GAS f32x4*)(F.ln_b + hc_o), lb1 = *(const GAS f32x4*)(F.ln_b + hc_o + 4);
          const f32x4 o0 = d0 * rs * lw0 + lb0 + v0 * bon, o1 = d1 * rs * lw1 + lb1 + v1 * bon;
          v4u ow; ow.x = pk2(o0[0], o0[1]); ow.y = pk2(o0[2], o0[3]); ow.z = pk2(o1[0], o1[1]); ow.w = pk2(o1[2], o1[3]);
          *(GAS v4u*)(F.OR + ((size_t)b * SEQ + t0 + otok) * 512 + hc_o) = ow; }
        __syncthreads();
    }
#undef RW_LOAD
#undef PIECE
    __syncthreads();
}
}

__device__ __forceinline__ void p456_chain(Frame& F) {
        const pg8::PanelOrder S{F.vcu, 4};
        { pg8::Gemm g{F.A1, F.WTA, M, D, 512}; pg8::EpiMerge<false> E{F.SGA, F.MG};
          pg8::gemm_phase<pg8::EpiMerge<false>, pg8::PanelOrder, true, true>(F.lds, g, S, E); }
        VM_WAIT(); __syncthreads();
        { pg8::Gemm g{F.A2, F.WTB, M, D, 512}; pg8::EpiMerge<true> E{F.SGB, F.MG};
          pg8::gemm_phase<pg8::EpiMerge<true>, pg8::PanelOrder, true, true>(F.lds, g, S, E); }
        VM_WAIT(); __syncthreads();
        if (threadIdx.x == 0) { __builtin_amdgcn_fence(__ATOMIC_ACQUIRE, "agent"); VM_WAIT(); }
        LAS float* ss = (LAS float*)(F.lds + SS_OFF);
        if (threadIdx.x < 256) ss[threadIdx.x] = 0.f;
        __syncthreads();
        { pg8::Gemm g{F.MG, F.WTO, M, D, D}; pg8::EpiOut E{F.out, ss};
          pg8::gemm_phase<pg8::EpiOut, pg8::PanelOrder, true, true>(F.lds, g, S, E); }
        VM_WAIT(); LDS_WAIT(); __syncthreads();
        if (threadIdx.x == 0) { __builtin_amdgcn_fence(__ATOMIC_ACQUIRE, "agent"); VM_WAIT(); }
        __syncthreads();
        int t2 = threadIdx.x; asm volatile("" : "+v"(t2)); const int lane2 = t2 & 63, wave2 = __builtin_amdgcn_readfirstlane(t2 >> 6);
        for (int r = wave2; r < 256; r += NWAVES) { const size_t row = (size_t)F.vcu * 256 + r; const float rstd = 1.0f / sqrtf(ss[r] * (1.0f / D) + RMS_EPS);
            GAS f32x4* op = (GAS f32x4*)(F.out + row * D) + lane2; const GAS f32x4* xp = (const GAS f32x4*)(F.x + row * D) + lane2; const GAS f32x4* gp = (const GAS f32x4*)F.post_g + lane2;
#pragma unroll
            for (int j = 0; j < 4; ++j) { const f32x4 raw = op[64 * j]; op[64 * j] = xp[64 * j] + raw * rstd * gp[64 * j]; } }
    }

#ifndef MK_N_LAUNCHES
#define MK_N_LAUNCHES 1
#endif
constexpr int N_LAUNCHES = MK_N_LAUNCHES;
#ifndef REP_P0
#define REP_P0 1
#endif
#ifndef REP_P1
#define REP_P1 1
#endif
#ifndef REP_SCAN
#define REP_SCAN 1
#endif
#ifndef REP_P3
#define REP_P3 1
#endif
#ifndef REP_P4
#define REP_P4 1
#endif
constexpr int N_PHASES = 5;
struct Args { const float* in[18]; float* out; unsigned char* ws; int ph_lo, ph_hi; };
__global__ void __launch_bounds__(NWAVES * 64, 2) mk_fwd(Args args) {
    extern __shared__ __attribute__((aligned(16))) unsigned char lds[];
    Frame F;
    F.lds = (LAS unsigned char*)lds;
    F.MISC = (volatile LAS unsigned*)(F.lds + MISC_OFF);
    F.tid = threadIdx.x; F.lane = F.tid & 63; F.wave = __builtin_amdgcn_readfirstlane(F.tid >> 6);
    F.G = gridDim.x; { const int bx = blockIdx.x; F.vcu = (F.G % 8 == 0) ? (bx % 8) * (F.G / 8) + bx / 8 : bx; }
    unsigned char* ws = args.ws;
    F.ctl = (gu32*)(ws + WS_CTL);
    F.x = args.in[0]; F.pre_g = args.in[1]; F.w_in = args.in[2]; F.rel_bias = args.in[3]; F.mix = args.in[4]; F.w0 = args.in[5]; F.w_up = args.in[6]; F.a0 = args.in[7]; F.a_up = args.in[8];
    F.k_k = args.in[9]; F.k_a = args.in[10]; F.r_k = args.in[11]; F.ln_w = args.in[12]; F.ln_b = args.in[13]; F.w_upA = args.in[14]; F.w_upB = args.in[15]; F.w_out = args.in[16]; F.post_g = args.in[17];
    F.out = args.out;
    F.WT1 = (bf16*)(ws + WS_WT1); F.WTA = (bf16*)(ws + WS_WTA); F.WTB = (bf16*)(ws + WS_WTB); F.WTO = (bf16*)(ws + WS_WTO); F.LSE = (float*)(ws + WS_LSE);
    F.H = (bf16*)(ws + WS_H); F.QKV = (bf16*)(ws + WS_QKV); F.RW = (bf16*)(ws + WS_RW);
    F.SGA = (bf16*)(ws + WS_SGA); F.SGB = (bf16*)(ws + WS_SGB); F.A1 = (bf16*)(ws + WS_A1); F.A2 = (bf16*)(ws + WS_A2); F.MG = (bf16*)(ws + WS_MG);
    F.OA = (bf16*)((unsigned char*)args.out + OUT_OA); F.OR = (bf16*)((unsigned char*)args.out + OUT_OR);
    for (int u = F.tid; u < (LDS_BYTES - LDSCTL_OFF) / 4; u += NWAVES * 64) ((LAS unsigned*)(F.lds + LDSCTL_OFF))[u] = 0u;
    __syncthreads();
    XcdBarrier bar; bar.bar = (unsigned*)(F.ctl + CW_BAR); bar.x = 0; bar.st = nullptr;
    if (N_LAUNCHES == 1) bar = xcd_barrier_post((unsigned*)(F.ctl + CW_BAR), F.MISC + 8);
    const int lo = args.ph_lo, hi = args.ph_hi;
#define IN(k) (lo <= (k) && (k) < hi)
#define BOTH(k) (IN(k) && IN((k) + 1))
#define GRID_BAR() do { if (N_LAUNCHES == 1) xcd_barrier(bar); } while (0)

    if (IN(0)) { for (int rep = 0; rep < REP_P0; ++rep) p0_prologue(F); if (BOTH(0)) GRID_BAR(); }

    if (IN(1)) {
        pg8::Gemm g{F.H, F.WT1, M, N1, D}; pg8::StaticOrder S; S.init(M, N1, F.G, (int)blockIdx.x);
        pg8::Epi1 E{F.QKV, F.RW};
        pg8::gemm_phase<pg8::Epi1, pg8::StaticOrder, true, true>(F.lds, g, S, E);
#if REP_P1 == 2
        pg8::gemm_phase<pg8::Epi1, pg8::StaticOrder, true, true>(F.lds, g, S, E);
#endif
        if (BOTH(1)) GRID_BAR();
    }

    if (IN(2)) {
        att::attn_phase(F);
        for (int rep = 0; rep < REP_SCAN; ++rep) rwkv::scan_phase(F);
        if (BOTH(2)) GRID_BAR();
    }

    if (IN(3)) {
        pg8::Gemm g{F.H, F.WT1 + (size_t)N1 * D, M, N2, D}; pg8::StaticOrder S; S.init(M, N2, F.G, (int)blockIdx.x);
        pg8::Epi2 E{F.OA, F.OR, F.A1, F.A2, F.SGA, F.SGB};
        pg8::gemm_phase<pg8::Epi2, pg8::StaticOrder, true, true>(F.lds, g, S, E);
#if REP_P3 == 2
        pg8::gemm_phase<pg8::Epi2, pg8::StaticOrder, true, true>(F.lds, g, S, E);
#endif
        if (BOTH(3)) GRID_BAR();
    }

    if (IN(4) && F.vcu < M / 256) {
        p456_chain(F);
#if REP_P4 == 2
        p456_chain(F);
#endif
    }
#undef IN
#undef BOTH
#undef GRID_BAR
}

extern "C" void kernel_launch(void* const* d_in, const int* in_sizes, int n_in, void* d_out, int out_size, void* d_ws, size_t ws_size, hipStream_t stream) {
    static int grid = 0;
    if (grid == 0) {
        if (n_in != 18 || in_sizes[0] != M * D || out_size != M * D || ws_size < WS_END) { fprintf(stderr, "kernel_launch: unexpected shapes / workspace: n_in %d in0 %d out %d ws %zu (need %zu)\n", n_in, n_in > 0 ? in_sizes[0] : -1, out_size, ws_size, (size_t)WS_END); grid = -1; return; }
        int dev = 0, cus = 0, per_cu = 0;
        if (hipGetDevice(&dev) != hipSuccess || hipDeviceGetAttribute(&cus, hipDeviceAttributeMultiprocessorCount, dev) != hipSuccess) { grid = -1; return; }
        if (hipFuncSetAttribute((const void*)mk_fwd, hipFuncAttributeMaxDynamicSharedMemorySize, LDS_BYTES) != hipSuccess) { fprintf(stderr, "kernel_launch: hipFuncSetAttribute failed\n"); grid = -1; return; }
        if (hipOccupancyMaxActiveBlocksPerMultiprocessor(&per_cu, (const void*)mk_fwd, NWAVES * 64, LDS_BYTES) != hipSuccess || per_cu < 1) fprintf(stderr, "kernel_launch: occupancy query reports %d\n", per_cu);
        (void)hipGetLastError();
        grid = cus;
        if (grid != 256) fprintf(stderr, "kernel_launch: %d CUs (built for 256)\n", grid);
        fprintf(stderr, "kernel_launch: ws_size %zu, grid %d, per_cu %d\n", ws_size, grid, per_cu);
    }
    if (grid < 0) return;
    if (hipMemsetAsync((char*)d_ws + WS_CTL, 0, CTL_ZERO_BYTES, stream) != hipSuccess) return;
    Args a{};
    for (int i = 0; i < 18; ++i) a.in[i] = (const float*)d_in[i];
    a.out = (float*)d_out; a.ws = (unsigned char*)d_ws;
    for (int li = 0; li < N_LAUNCHES; ++li) {
        a.ph_lo = (N_LAUNCHES == 1) ? 0 : li; a.ph_hi = (N_LAUNCHES == 1) ? N_PHASES : li + 1;
        hipLaunchKernelGGL(mk_fwd, dim3(grid), dim3(NWAVES * 64), LDS_BYTES, stream, a);
        if (hipPeekAtLastError() != hipSuccess) { fprintf(stderr, "kernel_launch: launch %d failed\n", li); break; }
    }
}
```

```cpp
#include <hip/hip_runtime.h>
#include <cstdio>
#include <cstdint>
namespace pg8 {
#define PG8_LAS __attribute__((address_space(3)))
typedef unsigned short bf16_t;
typedef short bf16x8 __attribute__((ext_vector_type(8)));
typedef float f32x4 __attribute__((ext_vector_type(4)));
typedef unsigned u32x4 __attribute__((ext_vector_type(4)));
constexpr int BM = 256, BK = 64, HALF = 128, HTB = HALF * BK * 2  , STAGE_BYTES = 8 * HTB, NXCD = 8, WGM = 8;

__host__ __device__ __forceinline__ int lds_byte(int r, int c) { const int st = (r >> 4) * 2 + (c >> 5), rr = r & 15, cc = c & 31, ob = rr * 64 + cc * 2; return st * 1024 + (ob ^ (((ob >> 9) & 1) << 5)); }
__host__ __device__ __forceinline__ void stage_rc(int b, int& R, int& C) { const int st = b / 1024, sb = b % 1024, swz = sb ^ (((sb >> 9) & 1) << 5); R = (st >> 1) * 16 + swz / 64; C = (st & 1) * 32 + (swz % 64) / 2; }
__host__ __device__ __forceinline__ int perm32(int rho) { const int n = rho >> 4, i = rho & 15; return 8 * (i >> 2) + 4 * n + (i & 3); }

struct Unit { int pm, pn; };
struct Gemm { const bf16_t* A; const bf16_t* Bt; int M, N, K; };

struct StaticOrder {
    int nM, nN, nwg, G, c;
    __host__ __device__ void init(int M, int N, int G_, int c_) { nM = M / BM; nN = N / BM; nwg = nM * nN; G = G_; c = c_; }
    __host__ __device__ bool next(int i, Unit& u) const {
        const long L = (long)i * G + c; if (L >= nwg) return false;
        int wgid = (int)L; { const int q = nwg / NXCD, r = nwg % NXCD, xcd = wgid % NXCD, off = wgid / NXCD; wgid = (xcd < r ? xcd * (q + 1) : r * (q + 1) + (xcd - r) * q) + off; }
        const int nig = WGM * nN, gid = wgid / nig, fm = gid * WGM, gsz = (nM - fm) < WGM ? (nM - fm) : WGM;
        u.pm = fm + ((wgid % nig) % gsz); u.pn = (wgid % nig) / gsz; return true;
    }
    __device__ __forceinline__ void a_ready(const Unit&) const {}
    __device__ __forceinline__ void done(const Unit&) const {}
};

__device__ __forceinline__ unsigned cvt_pk_bf16(float lo, float hi) { unsigned r; asm volatile("v_cvt_pk_bf16_f32 %0, %1, %2" : "=v"(r) : "v"(lo), "v"(hi)); return r; }
typedef unsigned u32x4 __attribute__((ext_vector_type(4)));
typedef unsigned u32x2 __attribute__((ext_vector_type(2)));
__device__ __forceinline__ float bf_lo(unsigned w) { return __builtin_bit_cast(float, w << 16); }
__device__ __forceinline__ float bf_hi(unsigned w) { return __builtin_bit_cast(float, w & 0xffff0000u); }
__device__ __forceinline__ float sigmoid_f(float z) { return __builtin_amdgcn_rcpf(1.0f + __builtin_amdgcn_exp2f(-1.4426950408889634f * z)); }
constexpr float QSCALE = 0.125f * 1.4426950408889634f;

struct PanelOrder {
    int pm, nN;
    __device__ __forceinline__ bool next(int i, Unit& u) const { if (i >= nN) return false; u.pm = pm; u.pn = i; return true; }
    __device__ __forceinline__ void a_ready(const Unit&) const {}
    __device__ __forceinline__ void done(const Unit&) const {}
};

struct Epi1 {
    static constexpr bool PERM = true, AFTER_DRAIN = false;
    bf16_t* QKV; bf16_t* RW;
    __device__ __forceinline__ void operator()(const f32x4 (&acc)[2][2][4][2], const Unit& u, int wr, int wc, int fr, int fq) const {
        const int row0 = u.pm * BM + wr * 64 + fr;
        bf16_t* base; int ldc, colt; float sc = 1.f;
        if (u.pn < 18) { base = QKV; ldc = 4608; colt = u.pn * BM; if (u.pn < 6) sc = QSCALE; } else { base = RW; ldc = 1792; colt = (u.pn - 18) * BM; }
        const int col0 = colt + wc * 32 + 8 * fq;
#pragma unroll
        for (int ai = 0; ai < 2; ++ai)
#pragma unroll
            for (int m = 0; m < 4; ++m) { bf16_t* rowp = base + (size_t)(row0 + ai * HALF + m * 16) * ldc + col0;
#pragma unroll
                for (int bj = 0; bj < 2; ++bj) { const f32x4 v0 = acc[ai][bj][m][0] * sc, v1 = acc[ai][bj][m][1] * sc;
                    u32x4 w; w.x = cvt_pk_bf16(v0[0], v0[1]); w.y = cvt_pk_bf16(v0[2], v0[3]); w.z = cvt_pk_bf16(v1[0], v1[1]); w.w = cvt_pk_bf16(v1[2], v1[3]);
                    *(u32x4*)(rowp + bj * HALF) = w; } }
    }
};

struct Epi2 {
    static constexpr bool PERM = true, AFTER_DRAIN = false;
    const bf16_t* OA; const bf16_t* OR; bf16_t* A1; bf16_t* A2; bf16_t* SGA; bf16_t* SGB;
    __device__ __forceinline__ void operator()(const f32x4 (&acc)[2][2][4][2], const Unit& u, int wr, int wc, int fr, int fq) const {
        const int row0 = u.pm * BM + wr * 64 + fr;
        const bf16_t* mul; bf16_t* dst; int ldc, colt;
        if (u.pn < 2) { mul = OA; dst = A1; ldc = 512; colt = u.pn * BM; }
        else if (u.pn < 4) { mul = OR; dst = A2; ldc = 512; colt = (u.pn - 2) * BM; }
        else if (u.pn < 8) { mul = nullptr; dst = SGA; ldc = 1024; colt = (u.pn - 4) * BM; }
        else { mul = nullptr; dst = SGB; ldc = 1024; colt = (u.pn - 8) * BM; }
        const int col0 = colt + wc * 32 + 8 * fq;
#pragma unroll
        for (int ai = 0; ai < 2; ++ai)
#pragma unroll
            for (int m = 0; m < 4; ++m) { const size_t off = (size_t)(row0 + ai * HALF + m * 16) * ldc + col0;
#pragma unroll
                for (int bj = 0; bj < 2; ++bj) { const f32x4 z0 = acc[ai][bj][m][0], z1 = acc[ai][bj][m][1];
                    float f[8];
#pragma unroll
                    for (int e = 0; e < 4; ++e) { f[e] = sigmoid_f(z0[e]); f[4 + e] = sigmoid_f(z1[e]); }
                    if (mul) { const u32x4 o = *(const u32x4*)(mul + off + bj * HALF);
#pragma unroll
                        for (int e = 0; e < 4; ++e) { f[e] *= z0[e]; f[4 + e] *= z1[e]; }
                        f[0] *= bf_lo(o.x); f[1] *= bf_hi(o.x); f[2] *= bf_lo(o.y); f[3] *= bf_hi(o.y); f[4] *= bf_lo(o.z); f[5] *= bf_hi(o.z); f[6] *= bf_lo(o.w); f[7] *= bf_hi(o.w); }
                    u32x4 w; w.x = cvt_pk_bf16(f[0], f[1]); w.y = cvt_pk_bf16(f[2], f[3]); w.z = cvt_pk_bf16(f[4], f[5]); w.w = cvt_pk_bf16(f[6], f[7]);
                    *(u32x4*)(dst + off + bj * HALF) = w; } }
    }
};

struct PanelOrder2 {
    int pm;
    __device__ __forceinline__ bool next(int i, Unit& u) const { if (i >= 8) return false; u.pm = pm + (i >= 4 ? 256 : 0); u.pn = i; return true; }
    __device__ __forceinline__ void a_ready(const Unit&) const {}
    __device__ __forceinline__ void done(const Unit&) const {}
};
struct EpiMerge2 {
    static constexpr bool PERM = true, AFTER_DRAIN = false;
    const bf16_t* SGA; const bf16_t* SGB; bf16_t* MG;
    __device__ __forceinline__ void operator()(const f32x4 (&acc)[2][2][4][2], const Unit& u, int wr, int wc, int fr, int fq) const {
        const bool add = u.pn >= 4; const bf16_t* SG = add ? SGB : SGA;
        const int row0 = (u.pm & 255) * BM + wr * 64 + fr, col0 = (u.pn & 3) * BM + wc * 32 + 8 * fq;
#pragma unroll
        for (int ai = 0; ai < 2; ++ai)
#pragma unroll
            for (int m = 0; m < 4; ++m) { const size_t off = (size_t)(row0 + ai * HALF + m * 16) * 1024 + col0;
#pragma unroll
                for (int bj = 0; bj < 2; ++bj) { const f32x4 z0 = acc[ai][bj][m][0], z1 = acc[ai][bj][m][1];
                    const u32x4 g = *(const u32x4*)(SG + off + bj * HALF);
                    float f[8];
                    f[0] = z0[0] * bf_lo(g.x); f[1] = z0[1] * bf_hi(g.x); f[2] = z0[2] * bf_lo(g.y); f[3] = z0[3] * bf_hi(g.y);
                    f[4] = z1[0] * bf_lo(g.z); f[5] = z1[1] * bf_hi(g.z); f[6] = z1[2] * bf_lo(g.w); f[7] = z1[3] * bf_hi(g.w);
                    if (add) { const u32x4 p = *(const u32x4*)(MG + off + bj * HALF);
                        f[0] += bf_lo(p.x); f[1] += bf_hi(p.x); f[2] += bf_lo(p.y); f[3] += bf_hi(p.y); f[4] += bf_lo(p.z); f[5] += bf_hi(p.z); f[6] += bf_lo(p.w); f[7] += bf_hi(p.w); }
                    u32x4 w; w.x = cvt_pk_bf16(f[0], f[1]); w.y = cvt_pk_bf16(f[2], f[3]); w.z = cvt_pk_bf16(f[4], f[5]); w.w = cvt_pk_bf16(f[6], f[7]);
                    *(u32x4*)(MG + off + bj * HALF) = w; } }
    }
};

struct EpiOut {
    static constexpr bool PERM = true, AFTER_DRAIN = false;
    float* OUT; PG8_LAS float* ss;
    __device__ __forceinline__ void operator()(const f32x4 (&acc)[2][2][4][2], const Unit& u, int wr, int wc, int fr, int fq) const {
        const int row0 = u.pm * BM + wr * 64 + fr, col0 = u.pn * BM + wc * 32 + 8 * fq;
#pragma unroll
        for (int ai = 0; ai < 2; ++ai)
#pragma unroll
            for (int m = 0; m < 4; ++m) { bf16_t* rowp = (bf16_t*)(OUT + (size_t)(row0 + ai * HALF + m * 16) * 1024) + col0; float q = 0.f;
#pragma unroll
                for (int bj = 0; bj < 2; ++bj) { const f32x4 z0 = acc[ai][bj][m][0], z1 = acc[ai][bj][m][1];
                    q += (z0[0] * z0[0] + z0[1] * z0[1]) + (z0[2] * z0[2] + z0[3] * z0[3]) + (z1[0] * z1[0] + z1[1] * z1[1]) + (z1[2] * z1[2] + z1[3] * z1[3]);
                    u32x4 w; w.x = cvt_pk_bf16(z0[0], z0[1]); w.y = cvt_pk_bf16(z0[2], z0[3]); w.z = cvt_pk_bf16(z1[0], z1[1]); w.w = cvt_pk_bf16(z1[2], z1[3]);
                    *(u32x4*)(rowp + bj * HALF) = w; }
                q += __shfl_xor(q, 16); q += __shfl_xor(q, 32);
                if (fq == 0) __hip_atomic_fetch_add(ss + (ai * HALF + wr * 64 + m * 16 + fr), q, __ATOMIC_RELAXED, __HIP_MEMORY_SCOPE_WORKGROUP); }
    }
};

template <class Epi, class Sched, bool ALIGN_EPI = false, bool SP2 = false>
__device__ __forceinline__ void gemm_phase(PG8_LAS unsigned char* lds, const Gemm g, const Sched& S, const Epi& E) {
    const int tid = threadIdx.x, wid = __builtin_amdgcn_readfirstlane(tid >> 6), lane = tid & 63, wr = wid >> 2, wc = wid & 3, fr = lane & 15, fq = lane >> 4;
    const int K = g.K, nt = K / BK;
    unsigned voffA[2], voffB[2];
#pragma unroll
    for (int i = 0; i < 2; ++i) { int R, C; stage_rc(tid * 16 + i * 8192, R, C); const int Rb = Epi::PERM ? ((R & ~31) + perm32(R & 31)) : R;
        voffA[i] = (unsigned)(R * K + C) * 2u; voffB[i] = (unsigned)(Rb * K + C) * 2u; }
    const size_t kstep = (size_t)(BK * 2);
    const size_t hstep = (size_t)HALF * K * 2;
    const size_t tstep = 2 * hstep;
    const unsigned ldsw = (unsigned)wid * 1024u;
    const int aoff = lds_byte(wr * 64 + fr, fq * 8), boff = lds_byte(wc * 32 + fr, fq * 8);
#define PG8_SA(b, h) (((b) * 2 + (h)) * HTB)
#define PG8_SB(b, h) ((4 + (b) * 2 + (h)) * HTB)
#define PG8_STAGE(bufoff, gbase, voff) do { _Pragma("unroll") for (int _i = 0; _i < 2; ++_i) \
        __builtin_amdgcn_global_load_lds((const unsigned*)((const char*)(gbase) + (voff)[_i]), (PG8_LAS unsigned*)(lds + (bufoff) + ldsw + _i * 8192), 16, 0, 0); } while (0)
#define PG8_LDA(dst, b, h) do { _Pragma("unroll") for (int m = 0; m < 4; ++m) _Pragma("unroll") for (int k = 0; k < 2; ++k) dst[m][k] = *(const PG8_LAS bf16x8*)(lds + PG8_SA(b, h) + aoff + m * 2048 + k * 1024); } while (0)
#define PG8_LDB(dst, b, h) do { _Pragma("unroll") for (int n = 0; n < 2; ++n) _Pragma("unroll") for (int k = 0; k < 2; ++k) dst[n][k] = *(const PG8_LAS bf16x8*)(lds + PG8_SB(b, h) + boff + n * 2048 + k * 1024); } while (0)
#define PG8_MMA(ai, bj, At, Bt) do { __builtin_amdgcn_s_setprio(1); _Pragma("unroll") for (int m = 0; m < 4; ++m) _Pragma("unroll") for (int n = 0; n < 2; ++n) _Pragma("unroll") for (int k = 0; k < 2; ++k) \
        acc[ai][bj][m][n] = __builtin_amdgcn_mfma_f32_16x16x32_bf16(Bt[n][k], At[m][k], acc[ai][bj][m][n], 0, 0, 0); __builtin_amdgcn_s_setprio(0); } while (0)
#define PG8_WAIT_V(n) asm volatile("s_waitcnt vmcnt(" #n ")" ::: "memory")
#define PG8_WAIT_L(n) asm volatile("s_waitcnt lgkmcnt(" #n ")" ::: "memory")
#define PG8_BAR __builtin_amdgcn_s_barrier()
#define PG8_SCHED __builtin_amdgcn_sched_barrier(0)
    Unit cur, nxt; int ui = 0;
    if (!S.next(0, cur)) return;
    f32x4 acc[2][2][4][2];
#pragma unroll
    for (int a = 0; a < 2; ++a)
#pragma unroll
        for (int b = 0; b < 2; ++b)
#pragma unroll
            for (int m = 0; m < 4; ++m)
#pragma unroll
                for (int n = 0; n < 2; ++n) acc[a][b][m][n] = (f32x4){0.f, 0.f, 0.f, 0.f};
    bf16x8 At[4][2], B0[2][2], B1[2][2];
    const char* cA = (const char*)g.A + (size_t)cur.pm * tstep; const char* cB = (const char*)g.Bt + (size_t)cur.pn * tstep;
    S.a_ready(cur);
    if constexpr (SP2) {
        PG8_STAGE(PG8_SB(0, 0), cB, voffB); PG8_STAGE(PG8_SB(0, 1), cB + hstep, voffB); PG8_STAGE(PG8_SA(0, 0), cA, voffA); PG8_STAGE(PG8_SA(0, 1), cA + hstep, voffA);
        if (wr == 1) PG8_BAR;
        PG8_WAIT_V(2); PG8_BAR;
        PG8_STAGE(PG8_SB(1, 0), cB + kstep, voffB); PG8_STAGE(PG8_SA(1, 0), cA + kstep, voffA); PG8_STAGE(PG8_SB(1, 1), cB + hstep + kstep, voffB);
        PG8_WAIT_V(6); PG8_BAR;
    } else {
        PG8_STAGE(PG8_SB(0, 0), cB, voffB); PG8_STAGE(PG8_SA(0, 0), cA, voffA); PG8_STAGE(PG8_SB(0, 1), cB + hstep, voffB); PG8_STAGE(PG8_SA(0, 1), cA + hstep, voffA);
        if (wr == 1) PG8_BAR;
        PG8_WAIT_V(4); PG8_BAR;
        PG8_STAGE(PG8_SB(1, 0), cB + kstep, voffB); PG8_STAGE(PG8_SA(1, 0), cA + kstep, voffA); PG8_STAGE(PG8_SB(1, 1), cB + hstep + kstep, voffB);
        PG8_WAIT_V(6); PG8_BAR;
    }
    for (;;) {
        const bool has_next = S.next(ui + 1, nxt);
        const char* nA = has_next ? (const char*)g.A + (size_t)nxt.pm * tstep : cA; const char* nB = has_next ? (const char*)g.Bt + (size_t)nxt.pn * tstep : cB;
        for (int t = 0; t < nt; t += 2) {
            const bool last = (t == nt - 2);
            const char* a1 = cA + (size_t)(t + 1) * kstep;
            const char* a2 = last ? nA : cA + (size_t)(t + 2) * kstep; const char* b2 = last ? nB : cB + (size_t)(t + 2) * kstep;
            const char* a3 = a2 + kstep; const char* b3 = b2 + kstep;
            if (last && has_next) S.a_ready(nxt);
            if constexpr (SP2) {
            PG8_LDB(B0, 0, 0); PG8_LDB(B1, 0, 1); PG8_SCHED; PG8_LDA(At, 0, 0); PG8_STAGE(PG8_SA(1, 1), a1 + hstep, voffA);
            PG8_WAIT_V(8); PG8_WAIT_L(0); PG8_BAR; PG8_MMA(0, 0, At, B0); PG8_MMA(0, 1, At, B1); PG8_BAR; PG8_SCHED;
            PG8_LDA(At, 0, 1); PG8_STAGE(PG8_SB(0, 0), b2, voffB); PG8_STAGE(PG8_SB(0, 1), b2 + hstep, voffB); PG8_STAGE(PG8_SA(0, 0), a2, voffA);
            PG8_WAIT_V(8); PG8_WAIT_L(0); PG8_BAR; PG8_MMA(1, 0, At, B0); PG8_MMA(1, 1, At, B1); PG8_BAR; PG8_SCHED;
            PG8_LDB(B0, 1, 0); PG8_LDB(B1, 1, 1); PG8_SCHED; PG8_LDA(At, 1, 0); PG8_STAGE(PG8_SA(0, 1), a2 + hstep, voffA);
            PG8_WAIT_V(8); PG8_WAIT_L(0); PG8_BAR; PG8_MMA(0, 0, At, B0); PG8_MMA(0, 1, At, B1); PG8_BAR; PG8_SCHED;
            PG8_LDA(At, 1, 1); PG8_STAGE(PG8_SB(1, 0), b3, voffB); PG8_STAGE(PG8_SB(1, 1), b3 + hstep, voffB); PG8_STAGE(PG8_SA(1, 0), a3, voffA);
            PG8_WAIT_V(8); PG8_WAIT_L(0); PG8_BAR; PG8_MMA(1, 0, At, B0); PG8_MMA(1, 1, At, B1); PG8_BAR; PG8_SCHED;
            } else {
            PG8_LDB(B0, 0, 0); PG8_SCHED; PG8_LDA(At, 0, 0); PG8_STAGE(PG8_SA(1, 1), a1 + hstep, voffA);
            PG8_WAIT_L(8); PG8_BAR; PG8_WAIT_L(0); PG8_MMA(0, 0, At, B0); PG8_BAR; PG8_SCHED;
            PG8_LDB(B1, 0, 1); PG8_STAGE(PG8_SB(0, 0), b2, voffB);
            PG8_BAR; PG8_WAIT_L(0); PG8_MMA(0, 1, At, B1); PG8_BAR;
            PG8_LDA(At, 0, 1); PG8_STAGE(PG8_SA(0, 0), a2, voffA);
            PG8_BAR; PG8_WAIT_L(0); PG8_MMA(1, 0, At, B0); PG8_BAR; PG8_SCHED;
            PG8_STAGE(PG8_SB(0, 1), b2 + hstep, voffB);
            PG8_WAIT_V(6); PG8_BAR; PG8_MMA(1, 1, At, B1); PG8_BAR;
            PG8_LDB(B0, 1, 0); PG8_SCHED; PG8_LDA(At, 1, 0); PG8_STAGE(PG8_SA(0, 1), a2 + hstep, voffA);
            PG8_WAIT_L(8); PG8_BAR; PG8_WAIT_L(0); PG8_MMA(0, 0, At, B0); PG8_BAR; PG8_SCHED;
            PG8_LDB(B1, 1, 1); PG8_STAGE(PG8_SB(1, 0), b3, voffB);
            PG8_BAR; PG8_WAIT_L(0); PG8_MMA(0, 1, At, B1); PG8_BAR;
            PG8_LDA(At, 1, 1); PG8_STAGE(PG8_SA(1, 0), a3, voffA);
            PG8_BAR; PG8_WAIT_L(0); PG8_MMA(1, 0, At, B0); PG8_BAR; PG8_SCHED;
            PG8_STAGE(PG8_SB(1, 1), b3 + hstep, voffB);
            PG8_WAIT_V(6); PG8_BAR; PG8_MMA(1, 1, At, B1); PG8_BAR;
            }
        }
        if constexpr (ALIGN_EPI) { if (wr == 0) PG8_BAR; }
        if constexpr (!Epi::AFTER_DRAIN) { E(acc, cur, wr, wc, fr, fq); S.done(cur); }
        if (!has_next) break;
#pragma unroll
        for (int a = 0; a < 2; ++a)
#pragma unroll
            for (int b = 0; b < 2; ++b)
#pragma unroll
                for (int m = 0; m < 4; ++m)
#pragma unroll
                    for (int n = 0; n < 2; ++n) acc[a][b][m][n] = (f32x4){0.f, 0.f, 0.f, 0.f};
        cur = nxt; cA = nA; cB = nB; ++ui;
        if constexpr (ALIGN_EPI) { if (wr == 1) PG8_BAR; }
    }
    PG8_WAIT_V(0);
    if constexpr (!ALIGN_EPI) { if (wr == 0) PG8_BAR; }
    PG8_BAR;
    if constexpr (Epi::AFTER_DRAIN) { E.fused(acc, cur, wr, wc, fr, fq, lds, wid, lane); S.done(cur); }
#undef PG8_SA
#undef PG8_SB
#undef PG8_STAGE
#undef PG8_LDA
#undef PG8_LDB
#undef PG8_MMA
#undef PG8_WAIT_V
#undef PG8_WAIT_L
#undef PG8_BAR
#undef PG8_SCHED
}
}

constexpr int NWAVES = 8;
constexpr int BATCH = 32, SEQ = 2048, D = 1024, M = BATCH * SEQ;
constexpr int NQKV = 4608, RW_LD = 1792, LDW_IN = 9344;
constexpr int N1 = 6400, N2 = 3072, WT1_ROWS = N1 + N2;
constexpr int OFF_ATTN_GATE = 4608, OFF_RWKV = 5120, OFF_RWKV_GATE = 6784, OFF_MERGE = 7296;
constexpr float RMS_EPS = 1e-6f, GN_EPS = 64e-5f;
constexpr float LOG2E = 1.4426950408889634f;

constexpr size_t MiB = 1u << 20;
constexpr size_t WS_CTL = 0, CTL_ZERO_BYTES = 1 * MiB;
constexpr size_t WS_WT1 = 2 * MiB, WS_WTA = 22 * MiB, WS_WTB = 23 * MiB, WS_WTO = 24 * MiB, WS_LSE = 26 * MiB;
constexpr size_t WS_H = 32 * MiB, WS_QKV = 160 * MiB, WS_RW = 736 * MiB, WS_END = 960 * MiB;
constexpr size_t WS_SGA = 160 * MiB, WS_SGB = 288 * MiB, WS_A1 = 416 * MiB, WS_A2 = 480 * MiB, WS_MG = 544 * MiB;
static_assert(WS_WT1 + (size_t)WT1_ROWS * D * 2 <= WS_WTA && WS_LSE + (size_t)3 * M * 8 * 4 <= WS_H && WS_H + (size_t)M * D * 2 <= WS_QKV && WS_QKV + (size_t)M * NQKV * 2 <= WS_RW && WS_RW + (size_t)M * RW_LD * 2 <= WS_END && WS_MG + (size_t)M * D * 2 <= WS_RW, "d_ws map");
constexpr size_t OUT_OA = 0, OUT_OR = 64 * MiB;
constexpr int CW_BAR = 4096;

constexpr int RING_BYTES = 131072;
constexpr int LDS_BYTES = 163840;
constexpr int LDSCTL_OFF = LDS_BYTES - 2048, MISC_OFF = LDSCTL_OFF + 320, SS_OFF = MISC_OFF + 128;
static_assert(SS_OFF + 1024 <= LDS_BYTES, "LDS map");

#define GAS __attribute__((address_space(1)))
#define LAS __attribute__((address_space(3)))
typedef unsigned short bf16;
typedef unsigned v4u __attribute__((ext_vector_type(4)));
typedef unsigned v2u __attribute__((ext_vector_type(2)));
typedef float f32x4 __attribute__((ext_vector_type(4)));
typedef short bf16x8 __attribute__((ext_vector_type(8)));
typedef short s16x4 __attribute__((ext_vector_type(4)));
typedef GAS unsigned gu32;
#define LDS_WAIT() asm volatile("s_waitcnt lgkmcnt(0)" ::: "memory")
#define VM_WAIT() asm volatile("s_waitcnt vmcnt(0)" ::: "memory")
__device__ __forceinline__ unsigned f2bf(float f) { unsigned u = __builtin_bit_cast(unsigned, f); return (u + 0x7fffu + ((u >> 16) & 1u)) >> 16; }
__device__ __forceinline__ unsigned pk2(float lo, float hi) { return f2bf(lo) | (f2bf(hi) << 16); }
__device__ __forceinline__ float bflo(unsigned w) { return __builtin_bit_cast(float, w << 16); }
__device__ __forceinline__ float bfhi(unsigned w) { return __builtin_bit_cast(float, w & 0xffff0000u); }
template <int CTRL> __device__ __forceinline__ float dpp_f(float v) { return __builtin_bit_cast(float, __builtin_amdgcn_update_dpp(0, __builtin_bit_cast(int, v), CTRL, 0xF, 0xF, false)); }
__device__ __forceinline__ float sum4(float v) { v += dpp_f<0xB1>(v); v += dpp_f<0x4E>(v); return v; }
__device__ __forceinline__ float sum8(float v) { v = sum4(v); v += dpp_f<0x141>(v); return v; }
__device__ __forceinline__ float sum16(float v) { v = sum8(v); v += dpp_f<0x140>(v); return v; }
__device__ __forceinline__ float max16(float v) { v = fmaxf(v, dpp_f<0xB1>(v)); v = fmaxf(v, dpp_f<0x4E>(v)); v = fmaxf(v, dpp_f<0x141>(v)); v = fmaxf(v, dpp_f<0x140>(v)); return v; }
__device__ __forceinline__ float sigm(float z) { return __builtin_amdgcn_rcpf(1.0f + __builtin_amdgcn_exp2f(-LOG2E * z)); }
#define XB_TMO      128
#define XB_XCNT(j)  (256  + 64 * (j))
#define XB_XSUB(j)  (1280 + 64 * (j))
#define XB_XGEN(j)  (2304 + 64 * (j))
#define XB_TOP      3328
#define XB_TOPGEN   3392
#define XCD_BAR_WORDS 3456
#define XB_SPIN_CAP (1u << 18)

__device__ __forceinline__ unsigned xb_ld(unsigned* p)              { return __hip_atomic_load(p, __ATOMIC_RELAXED, __HIP_MEMORY_SCOPE_AGENT); }
__device__ __forceinline__ unsigned xb_add(unsigned* p, unsigned v) { return __hip_atomic_fetch_add(p, v, __ATOMIC_RELAXED, __HIP_MEMORY_SCOPE_AGENT); }
__device__ __forceinline__ unsigned xb_xcc_id() { return (unsigned)__builtin_amdgcn_s_getreg((3 << 11) | 20) & 0xFu; }
#define XB_SPIN(cond, bar) do { unsigned _sp = 0; while (cond) { __builtin_amdgcn_s_sleep(1); \
    if ((++_sp & 255u) == 0u) { if (xb_ld(&(bar)[XB_TMO])) break; if (_sp > XB_SPIN_CAP) { atomicAdd(&(bar)[XB_TMO], 1u); break; } } } } while (0)

struct XcdBarrier {
    unsigned* bar; unsigned x;
    volatile LAS unsigned* st;
};

__device__ __forceinline__ XcdBarrier xcd_barrier_post(unsigned* bar, volatile LAS unsigned* st) {
    XcdBarrier b; b.bar = bar; b.x = xb_xcc_id(); b.st = st;
    if (threadIdx.x == 0) (void)xb_add(&bar[XB_XCNT(b.x)], 1u);
    return b;
}
__device__ __forceinline__ void xcd_barrier_complete(unsigned* bar, unsigned x, unsigned& nloc, unsigned& nx) {
    const unsigned G = gridDim.x * gridDim.y * gridDim.z;
    unsigned sum, cnt, mine, sp = 0u;
    for (;;) {
        sum = 0u; cnt = 0u; mine = 0u;
#pragma unroll
        for (unsigned j = 0; j < 16; ++j) { const unsigned c = xb_ld(&bar[XB_XCNT(j)]); sum += c; cnt += (c > 0u) ? 1u : 0u; mine = (j == x) ? c : mine; }
        if (sum == G) break;
        __builtin_amdgcn_s_sleep(1);
        if ((++sp & 255u) == 0u) { if (xb_ld(&bar[XB_TMO])) break; if (sp > XB_SPIN_CAP) { atomicAdd(&bar[XB_TMO], 1u); break; } }
    }
    nloc = mine > 0u ? mine : 1u; nx = cnt > 0u ? cnt : 1u;
}

__device__ __forceinline__ void xcd_barrier(const XcdBarrier& b) {
    asm volatile("s_waitcnt vmcnt(0)" ::: "memory");
    __syncthreads();
    if (threadIdx.x == 0) {
        unsigned* bar = b.bar;
        __builtin_amdgcn_s_waitcnt(0);
        unsigned nloc = b.st[0], nx = b.st[1];
        if (nloc == 0u) { xcd_barrier_complete(bar, b.x, nloc, nx); b.st[0] = nloc; b.st[1] = nx; }
        const unsigned old = xb_add(&bar[XB_XSUB(b.x)], 1u);
        const unsigned gen = old / nloc;
        if (old + 1u == (gen + 1u) * nloc) {
            __builtin_amdgcn_fence(__ATOMIC_RELEASE, "agent");
            asm volatile("s_waitcnt vmcnt(0)" ::: "memory");
            const unsigned og = xb_add(&bar[XB_TOP], 1u);
            const unsigned tg = og / nx;
            if (og + 1u == (tg + 1u) * nx) xb_add(&bar[XB_TOPGEN], 1u);
            else XB_SPIN(xb_ld(&bar[XB_TOPGEN]) == tg, bar);
            __builtin_amdgcn_fence(__ATOMIC_ACQUIRE, "agent");
            xb_add(&bar[XB_XGEN(b.x)], 1u);
            asm volatile("s_waitcnt vmcnt(0)" ::: "memory");
        } else {
            XB_SPIN(xb_ld(&bar[XB_XGEN(b.x)]) == gen, bar);
            __builtin_amdgcn_fence(__ATOMIC_ACQUIRE, "agent");
            asm volatile("s_waitcnt vmcnt(0)" ::: "memory");
        }
    }
    __syncthreads();
}

struct Frame {
    LAS unsigned char* lds;
    volatile LAS unsigned* MISC;
    gu32* ctl;
    int tid, lane, wave;
    int vcu, G;
    const float* x; float* out;
    const float *pre_g, *w_in, *rel_bias, *mix, *w0, *w_up, *a0, *a_up, *k_k, *k_a, *r_k, *ln_w, *ln_b, *w_upA, *w_upB, *w_out, *post_g;
    bf16 *WT1, *WTA, *WTB, *WTO, *H, *QKV, *RW, *SGA, *SGB, *A1, *A2, *MG, *OA, *OR;
    float* LSE;
};

__device__ __forceinline__ float wave_sum(float v) {
#pragma unroll
    for (int o = 1; o < 64; o <<= 1) v += __shfl_xor(v, o);
    return v;
}
__device__ __forceinline__ void p0_transpose_item(const float* W, int K, int ldw, int c0, int nblk, bf16* WT, int row_off, LAS float* scr, int item, int lane) {
    const int kb = item / nblk, nb = item % nblk, k0 = 64 * kb, n0 = 32 * nb;
#pragma unroll 8
    for (int i = 0; i < 32; ++i) { const int kk = 2 * i + (lane >> 5); scr[kk * 33 + (lane & 31)] = W[(size_t)(k0 + kk) * ldw + c0 + n0 + (lane & 31)]; }
    LDS_WAIT(); asm volatile("" ::: "memory");
    const int c = lane & 7;
#pragma unroll
    for (int j = 0; j < 4; ++j) { const int n = (lane >> 3) + 8 * j; const LAS float* s = scr + (8 * c) * 33 + n;
        v4u o; o.x = pk2(s[0 * 33], s[1 * 33]); o.y = pk2(s[2 * 33], s[3 * 33]); o.z = pk2(s[4 * 33], s[5 * 33]); o.w = pk2(s[6 * 33], s[7 * 33]);
        *(GAS v4u*)(WT + (size_t)(row_off + n0 + n) * K + k0 + 8 * c) = o; }
    LDS_WAIT(); asm volatile("" ::: "memory");
}
__device__ __forceinline__ void rms_row_to_bf16(Frame& F, const float* xrow, bf16* orow) {
    const GAS f32x4* xr = (const GAS f32x4*)xrow + F.lane; const GAS f32x4* gr = (const GAS f32x4*)F.pre_g + F.lane;
    f32x4 v[4]; float s = 0.f;
#pragma unroll
    for (int j = 0; j < 4; ++j) { v[j] = xr[64 * j]; s += (v[j].x * v[j].x + v[j].y * v[j].y) + (v[j].z * v[j].z + v[j].w * v[j].w); }
    const float rstd = 1.f / sqrtf(wave_sum(s) * (1.f / D) + RMS_EPS);
    GAS unsigned long long* o8 = (GAS unsigned long long*)orow + F.lane;
#pragma unroll
    for (int j = 0; j < 4; ++j) { const f32x4 g = gr[64 * j]; const f32x4 y = v[j] * rstd * g;
        o8[64 * j] = (unsigned long long)pk2(y.x, y.y) | ((unsigned long long)pk2(y.z, y.w) << 32); }
}
__device__ __forceinline__ void p0_prologue(Frame& F) {
    LAS float* scr = (LAS float*)(F.lds + F.wave * 16384);
    const int gw = F.vcu * NWAVES + F.wave, NGW = F.G * NWAVES;
    constexpr int I1 = 16 * 144, I2 = 16 * 52, I4 = 16 * 16, I5 = 16 * 16, I6 = 16 * 64, I7 = 8 * 32, I8 = 8 * 32, I9 = 16 * 32;
    constexpr int NITEMS = I1 + I2 + I4 + I5 + I6 + I7 + I8 + I9;
    for (int it = gw; it < NITEMS; it += NGW) {
        int r = it;
        if (r < I1) { p0_transpose_item(F.w_in, D, LDW_IN, 0, 144, F.WT1, 0, scr, r, F.lane); continue; } r -= I1;
        if (r < I2) { p0_transpose_item(F.w_in, D, LDW_IN, OFF_RWKV, 52, F.WT1, 4608, scr, r, F.lane); continue; } r -= I2;
        if (r < I4) { p0_transpose_item(F.w_in, D, LDW_IN, OFF_ATTN_GATE, 16, F.WT1, N1, scr, r, F.lane); continue; } r -= I4;
        if (r < I5) { p0_transpose_item(F.w_in, D, LDW_IN, OFF_RWKV_GATE, 16, F.WT1, N1 + 512, scr, r, F.lane); continue; } r -= I5;
        if (r < I6) { p0_transpose_item(F.w_in, D, LDW_IN, OFF_MERGE, 64, F.WT1, N1 + 1024, scr, r, F.lane); continue; } r -= I6;
        if (r < I7) { p0_transpose_item(F.w_upA, 512, D, 0, 32, F.WTA, 0, scr, r, F.lane); continue; } r -= I7;
        if (r < I8) { p0_transpose_item(F.w_upB, 512, D, 0, 32, F.WTB, 0, scr, r, F.lane); continue; } r -= I8;
        p0_transpose_item(F.w_out, D, D, 0, 32, F.WTO, 0, scr, r, F.lane);
    }
    { const int gt = F.vcu * (NWAVES * 64) + F.tid, NT = F.G * NWAVES * 64;
      for (int i = gt; i < 16384; i += NT) *((GAS v4u*)(F.WT1 + (size_t)6272 * D) + i) = (v4u){0u, 0u, 0u, 0u}; }
    for (int m = gw; m < M; m += NGW) rms_row_to_bf16(F, F.x + (size_t)m * D, F.H + (size_t)m * D);
}

namespace att {
constexpr int KSTR = 144;
constexpr int HALF_B = 128 * KSTR;
constexpr int KS_OFF = 0, VS_OFF = 3 * HALF_B, OST_OFF = 6 * HALF_B, OST_WAVE = 16 * KSTR, LST_OFF = OST_OFF + 8 * OST_WAVE, BIAS_OFF = LST_OFF + 8 * 64, END_OFF = BIAS_OFF + 3 * 544;
static_assert(END_OFF <= LDSCTL_OFF, "attention LDS");
typedef short v4i16_t __attribute__((ext_vector_type(4)));
typedef float f32x2_t __attribute__((ext_vector_type(2)));
typedef __bf16 bf16x2_t __attribute__((ext_vector_type(2)));
__device__ __forceinline__ s16x4 vtr(LAS const unsigned char* p) { return __builtin_bit_cast(s16x4, __builtin_amdgcn_ds_read_tr16_b64_v4i16((LAS v4i16_t*)p)); }
__device__ __forceinline__ unsigned cvt2(float lo, float hi) { f32x2_t v = {lo, hi}; bf16x2_t b = __builtin_convertvector(v, bf16x2_t); return __builtin_bit_cast(unsigned, b); }
__device__ __forceinline__ int t5_bucket(int d) {
    if (d < 16) return d;
    int b = 16;
    b += (d >= 22); b += (d >= 30); b += (d >= 40); b += (d >= 54); b += (d >= 73); b += (d >= 99); b += (d >= 134); b += (d >= 182);
    b += (d >= 246); b += (d >= 332); b += (d >= 450); b += (d >= 609); b += (d >= 825); b += (d >= 1117); b += (d >= 1513);
    return b;
}
__device__ __forceinline__ void blk_decode(int i, int& g, int& dil, int& r, int& n) {
    if (i < 16) { g = 0; dil = 1; r = 0; n = i; } else if (i < 32) { g = 1; dil = 4; r = (i - 16) >> 2; n = (i - 16) & 3; } else { g = 2; dil = 16; r = i - 32; n = 0; }
}

__device__ __forceinline__ void attn_phase(Frame& F) {
    LAS unsigned char* lds = F.lds;
    const int tid = F.tid, lane = F.lane, w = F.wave, c = lane & 15, q = lane >> 4;
    const int b = F.vcu >> 3, h = F.vcu & 7;
    if (F.vcu >= BATCH * 8) return;
    const float NEG_INF = -__builtin_inff();
    __syncthreads();
    for (int i = tid; i < 3 * 129; i += NWAVES * 64) { const int g = i / 129, rel = i % 129, dil = (g == 0) ? 1 : (g == 1) ? 4 : 16;
        ((LAS float*)(lds + BIAS_OFF + g * 544))[rel] = F.rel_bias[t5_bucket(rel * dil) * 24 + g * 8 + h] * LOG2E; }
    for (int i = tid; i < 6 * HALF_B / 16; i += NWAVES * 64) *(LAS v4u*)(lds + i * 16) = (v4u){0u, 0u, 0u, 0u};
    const bf16* Qb = F.QKV + (size_t)b * SEQ * NQKV + h * 64;
    LAS unsigned char* OSTw = lds + OST_OFF + w * OST_WAVE;
    LAS float* LSTw = (LAS float*)(lds + LST_OFF + w * 64);
    const int srow0 = tid >> 3, sch = tid & 7;
    v4u kreg[2], vreg[2]; bf16x8 aq[2];
#define ATT_LOAD(i) do { int g_, dil_, r_, n_; blk_decode((i), g_, dil_, r_, n_); const bf16* Qg_ = Qb + g_ * 512; \
        _Pragma("unroll") for (int it = 0; it < 2; ++it) { const bf16* p_ = Qg_ + (size_t)((n_ * 128 + srow0 + 64 * it) * dil_ + r_) * NQKV + sch * 8; kreg[it] = *(const GAS v4u*)(p_ + 1536); vreg[it] = *(const GAS v4u*)(p_ + 3072); } \
        { const bf16* qp_ = Qg_ + (size_t)((n_ * 128 + 16 * w + c) * dil_ + r_) * NQKV + 8 * q; aq[0] = *(const GAS bf16x8*)(qp_); aq[1] = *(const GAS bf16x8*)(qp_ + 32); } } while (0)
#define ATT_STORE(slot) do { _Pragma("unroll") for (int it = 0; it < 2; ++it) { const int o_ = (slot) * HALF_B + (srow0 + 64 * it) * KSTR + sch * 16; *(LAS v4u*)(lds + KS_OFF + o_) = kreg[it]; *(LAS v4u*)(lds + VS_OFF + o_) = vreg[it]; } } while (0)
    ATT_LOAD(0);
    __syncthreads();
    ATT_STORE(0);
    bf16x8 aqc[2] = {aq[0], aq[1]};
    __syncthreads();
    float bl[9][4];
    int gprev = -1;
#pragma unroll 1
    for (int i = 0; i < 48; ++i) {
        int g, dil, r, n; blk_decode(i, g, dil, r, n);
        const int cur = i % 3, prv = (i + 2) % 3;
        if (i + 1 < 48) ATT_LOAD(i + 1);
        if (g != gprev) { gprev = g; const LAS float* bias2 = (const LAS float*)(lds + BIAS_OFF + g * 544);
#pragma unroll
            for (int n16 = 0; n16 < 9; ++n16)
#pragma unroll
                for (int reg = 0; reg < 4; ++reg) { const int rel = 128 + c - 16 * n16 - 4 * q - reg; const int rc = rel < 0 ? 0 : (rel > 128 ? 128 : rel);
                    const float bv = bias2[rc]; bl[n16][reg] = (rel >= 0 && rel <= 128) ? bv : NEG_INF; } }
        f32x4 s[9]; float mx = NEG_INF;
#pragma unroll
        for (int n16 = 0; n16 < 9; ++n16) { const int kpos0 = 16 * w + 16 * n16; const int rowb = ((kpos0 >= 128) ? cur : prv) * 128 + (kpos0 & 127);
            f32x4 a = (f32x4){0.f, 0.f, 0.f, 0.f};
#pragma unroll
            for (int ks = 0; ks < 2; ++ks) { const bf16x8 kf = *(const LAS bf16x8*)(lds + KS_OFF + (rowb + c) * KSTR + (32 * ks + 8 * q) * 2);
                a = __builtin_amdgcn_mfma_f32_16x16x32_bf16(kf, aqc[ks], a, 0, 0, 0); }
            const bool ok = (n > 0) || (kpos0 >= 128);
#pragma unroll
            for (int reg = 0; reg < 4; ++reg) { const float v = ok ? a[reg] + bl[n16][reg] : NEG_INF; a[reg] = v; mx = fmaxf(mx, v); }
            s[n16] = a; }
        mx = fmaxf(mx, __shfl_xor(mx, 16)); mx = fmaxf(mx, __shfl_xor(mx, 32));
        float ls = 0.f; s16x4 pb[9];
#pragma unroll
        for (int n16 = 0; n16 < 9; ++n16) { const float p0 = __builtin_amdgcn_exp2f(s[n16][0] - mx), p1 = __builtin_amdgcn_exp2f(s[n16][1] - mx), p2 = __builtin_amdgcn_exp2f(s[n16][2] - mx), p3 = __builtin_amdgcn_exp2f(s[n16][3] - mx);
            ls += (p0 + p1) + (p2 + p3); v2u pk; pk.x = cvt2(p0, p1); pk.y = cvt2(p2, p3); pb[n16] = __builtin_bit_cast(s16x4, pk); }
        ls += __shfl_xor(ls, 16); ls += __shfl_xor(ls, 32);
        f32x4 o[4];
#pragma unroll
        for (int nd = 0; nd < 4; ++nd) o[nd] = (f32x4){0.f, 0.f, 0.f, 0.f};
#pragma unroll
        for (int n16 = 0; n16 < 9; ++n16) { const int kpos0 = 16 * w + 16 * n16; const int rowb = ((kpos0 >= 128) ? cur : prv) * 128 + (kpos0 & 127);
            LAS const unsigned char* vb = lds + VS_OFF + (rowb + 4 * q + (c >> 2)) * KSTR + (c & 3) * 8;
#pragma unroll
            for (int nd = 0; nd < 4; ++nd) o[nd] = __builtin_amdgcn_mfma_f32_16x16x16bf16_1k(pb[n16], vtr(vb + nd * 32), o[nd], 0, 0, 0); }
        if (q == 0) LSTw[c] = ls;
        const f32x4 l4 = *(const LAS f32x4*)(LSTw + 4 * q);
#pragma unroll
        for (int reg = 0; reg < 4; ++reg) { const float inv = __builtin_amdgcn_rcpf(l4[reg]);
#pragma unroll
            for (int nd = 0; nd < 4; ++nd) *(LAS unsigned short*)(OSTw + (4 * q + reg) * KSTR + (16 * nd + c) * 2) = (unsigned short)cvt2(o[nd][reg] * inv, 0.f); }
        const bf16* Qg = Qb + g * 512;
#pragma unroll
        for (int it = 0; it < 2; ++it) { const int id = lane + 64 * it, row = id >> 3, ch = id & 7;
            const v4u val = *(const LAS v4u*)(OSTw + row * KSTR + ch * 16);
            *(GAS v4u*)(Qg + (size_t)((n * 128 + 16 * w + row) * dil + r) * NQKV + ch * 8) = val; }
        if (q == 0) F.LSE[((size_t)g * M + (size_t)b * SEQ + (size_t)((n * 128 + 16 * w + c) * dil + r)) * 8 + h] = mx + __builtin_amdgcn_logf(ls);
        if (i + 1 < 48) { ATT_STORE((i + 1) % 3); aqc[0] = aq[0]; aqc[1] = aq[1]; }
        __syncthreads();
    }
#undef ATT_LOAD
#undef ATT_STORE
    VM_WAIT(); __syncthreads();
    if (tid == 0) { __builtin_amdgcn_fence(__ATOMIC_ACQUIRE, "agent"); VM_WAIT(); }
    __syncthreads();
    for (int p = tid; p < SEQ * 8; p += NWAVES * 64) { const int t = p >> 3, ch = p & 7; const size_t row = (size_t)b * SEQ + t;
        float l0 = F.LSE[((size_t)0 * M + row) * 8 + h], l1 = F.LSE[((size_t)1 * M + row) * 8 + h], l2 = F.LSE[((size_t)2 * M + row) * 8 + h];
        const float mm = fmaxf(l0, fmaxf(l1, l2)); float w0 = __builtin_amdgcn_exp2f(l0 - mm), w1 = __builtin_amdgcn_exp2f(l1 - mm), w2 = __builtin_amdgcn_exp2f(l2 - mm);
        const float wi = __builtin_amdgcn_rcpf(w0 + w1 + w2); w0 *= wi; w1 *= wi; w2 *= wi;
        const bf16* qp = F.QKV + row * NQKV + h * 64 + ch * 8;
        const v4u a = *(const GAS v4u*)(qp), bb = *(const GAS v4u*)(qp + 512), cc = *(const GAS v4u*)(qp + 1024);
        v4u o;
        o.x = pk2(w0 * bflo(a.x) + w1 * bflo(bb.x) + w2 * bflo(cc.x), w0 * bfhi(a.x) + w1 * bfhi(bb.x) + w2 * bfhi(cc.x));
        o.y = pk2(w0 * bflo(a.y) + w1 * bflo(bb.y) + w2 * bflo(cc.y), w0 * bfhi(a.y) + w1 * bfhi(bb.y) + w2 * bfhi(cc.y));
        o.z = pk2(w0 * bflo(a.z) + w1 * bflo(bb.z) + w2 * bflo(cc.z), w0 * bfhi(a.z) + w1 * bfhi(bb.z) + w2 * bfhi(cc.z));
        o.w = pk2(w0 * bflo(a.w) + w1 * bflo(bb.w) + w2 * bflo(cc.w), w0 * bfhi(a.w) + w1 * bfhi(bb.w) + w2 * bfhi(cc.w));
        *(GAS v4u*)(F.OA + row * 512 + h * 64 + ch * 8) = o; }
    __syncthreads();
}
}

namespace rwkv {
constexpr int TC = 64, RSTR = 144;
constexpr int WUPT_OFF = 0, AUPT_OFF = 9216, TW_OFF = 18432, AL_OFF = 27648, RAWF_OFF = 36864, Y_OFF = RAWF_OFF;
constexpr int AT_OFF = 86016, RT_OFF = 95232, BT_OFF = 104448, KT_OFF = 113664, VV_OFF = 122880;
constexpr int MK_OFF = 132096, PB_OFF = 134144, PK_OFF = 136192, TT_OFF = 138240, GAM_OFF = 140288, XS_OFF = 141312, SSQ_OFF = 145408, BON_OFF = 145664, END_OFF = 145920;
static_assert(END_OFF <= LDSCTL_OFF, "scan LDS");
typedef short v4i16_t __attribute__((ext_vector_type(4)));
typedef float f32x2_t __attribute__((ext_vector_type(2)));
typedef __bf16 bf16x2_t __attribute__((ext_vector_type(2)));
__device__ __forceinline__ s16x4 vtr(LAS const unsigned char* p) { return __builtin_bit_cast(s16x4, __builtin_amdgcn_ds_read_tr16_b64_v4i16((LAS v4i16_t*)p)); }
__device__ __forceinline__ unsigned cvt2(float lo, float hi) { f32x2_t v = {lo, hi}; bf16x2_t b = __builtin_convertvector(v, bf16x2_t); return __builtin_bit_cast(unsigned, b); }
__device__ __forceinline__ s16x4 pack4(const f32x4& x) { v2u p; p.x = cvt2(x[0], x[1]); p.y = cvt2(x[2], x[3]); return __builtin_bit_cast(s16x4, p); }
#define MFMA16(a, b, c) __builtin_amdgcn_mfma_f32_16x16x16bf16_1k((a), (b), (c), 0, 0, 0)
#define MFMA32(a, b, c) __builtin_amdgcn_mfma_f32_16x16x32_bf16((a), (b), (c), 0, 0, 0)

__device__ __forceinline__ void scan_phase(Frame& F) {
    LAS unsigned char* lds = F.lds;
    const int tid = F.tid, lane = F.lane, w = F.wave, c = lane & 15, q = lane >> 4;
    const int b = F.vcu >> 3, h = F.vcu & 7;
    if (F.vcu >= BATCH * 8) return;
    __syncthreads();
    for (int e = tid; e < 64 * 64; e += NWAVES * 64) { const int j = e >> 6, i = e & 63;
        *(LAS unsigned short*)(lds + WUPT_OFF + i * RSTR + j * 2) = (unsigned short)f2bf(F.w_up[j * 512 + h * 64 + i]);
        *(LAS unsigned short*)(lds + AUPT_OFF + i * RSTR + j * 2) = (unsigned short)f2bf(F.a_up[j * 512 + h * 64 + i]); }
    LAS float* RAWF = (LAS float*)(lds + RAWF_OFF);
    LAS float* Y = (LAS float*)(lds + Y_OFF);
    LAS float* GAM = (LAS float*)(lds + GAM_OFF);
    LAS float* SSQ = (LAS float*)(lds + SSQ_OFF);
    LAS float* BON = (LAS float*)(lds + BON_OFF);
    if (tid < 64) SSQ[tid] = 0.f;
    const bf16* RWb = F.RW + (size_t)b * SEQ * RW_LD;
    v4u cur[5], prv[5];
#define PIECE(it) const int p_ = tid + 512 * (it), tok_ = p_ / 40, rem_ = p_ % 40, run_ = rem_ >> 3, pc_ = rem_ & 7, col_ = (run_ < 3 ? run_ * 512 + h * 64 : (run_ == 3 ? 1536 : 1600)) + pc_ * 8
#define RW_LOAD(t0) do { _Pragma("unroll") for (int it = 0; it < 5; ++it) { PIECE(it); const int t = (t0) + tok_; cur[it] = *(const GAS v4u*)(RWb + (size_t)t * RW_LD + col_); \
        prv[it] = (v4u){0u, 0u, 0u, 0u}; if (t > 0) prv[it] = *(const GAS v4u*)(RWb + (size_t)(t - 1) * RW_LD + col_); } } while (0)
    RW_LOAD(0);
    const int nt = w & 3, ich = 16 * nt + c, hc_e = h * 64 + ich;
    const float p_w0 = F.w0[hc_e], p_a0 = F.a0[hc_e], p_kk = F.k_k[hc_e], p_ka = F.k_a[hc_e], p_rk = F.r_k[hc_e];
    const int otok = tid >> 3, opart = tid & 7, hc_o = h * 64 + 8 * opart;
    f32x4 ST[4];
#pragma unroll
    for (int n = 0; n < 4; ++n) ST[n] = (f32x4){0.f, 0.f, 0.f, 0.f};
    __syncthreads();
    for (int t0 = 0; t0 < SEQ; t0 += TC) {
        if (tid < 64) BON[tid] = 0.f;
#pragma unroll
        for (int it = 0; it < 5; ++it) { PIECE(it);
            const f32x4 m0 = *(const GAS f32x4*)(F.mix + col_), m1 = *(const GAS f32x4*)(F.mix + col_ + 4);
            float x[8];
            { const v4u cu = cur[it], pr = prv[it];
              const float cv[8] = {bflo(cu.x), bfhi(cu.x), bflo(cu.y), bfhi(cu.y), bflo(cu.z), bfhi(cu.z), bflo(cu.w), bfhi(cu.w)};
              const float pv[8] = {bflo(pr.x), bfhi(pr.x), bflo(pr.y), bfhi(pr.y), bflo(pr.z), bfhi(pr.z), bflo(pr.w), bfhi(pr.w)};
              const float mv[8] = {m0[0], m0[1], m0[2], m0[3], m1[0], m1[1], m1[2], m1[3]};
#pragma unroll
              for (int e = 0; e < 8; ++e) x[e] = cv[e] + (pv[e] - cv[e]) * mv[e]; }
            if (run_ < 3) { LAS float* d = RAWF + (tok_ * 3 + run_) * 64 + pc_ * 8;
                *(LAS f32x4*)d = (f32x4){x[0], x[1], x[2], x[3]}; *(LAS f32x4*)(d + 4) = (f32x4){x[4], x[5], x[6], x[7]};
                if (run_ == 1) { const f32x4 k0 = *(const GAS f32x4*)(F.k_k + h * 64 + pc_ * 8), k1 = *(const GAS f32x4*)(F.k_k + h * 64 + pc_ * 8 + 4);
                    float s = 0.f;
#pragma unroll
                    for (int e = 0; e < 4; ++e) { const float z0 = x[e] * k0[e], z1 = x[4 + e] * k1[e]; s += z0 * z0 + z1 * z1; }
                    __hip_atomic_fetch_add(SSQ + tok_, s, __ATOMIC_RELAXED, __HIP_MEMORY_SCOPE_WORKGROUP); } }
            else { if (run_ == 3) {
#pragma unroll
                    for (int e = 0; e < 8; ++e) { const float ex = __builtin_amdgcn_exp2f(2.0f * LOG2E * x[e]); x[e] = 1.0f - 2.0f * __builtin_amdgcn_rcpf(ex + 1.0f); } }
                v4u o; o.x = pk2(x[0], x[1]); o.y = pk2(x[2], x[3]); o.z = pk2(x[4], x[5]); o.w = pk2(x[6], x[7]);
                *(LAS v4u*)(lds + (run_ == 3 ? TW_OFF : AL_OFF) + tok_ * RSTR + pc_ * 16) = o; }
        }
        __syncthreads();
        if (t0 + TC < SEQ) RW_LOAD(t0 + TC);
#pragma unroll
        for (int half = 0; half < 2; ++half) { const int mt = 2 * (w >> 2) + half;
            f32x4 cw = (f32x4){0.f, 0.f, 0.f, 0.f}, ca = (f32x4){0.f, 0.f, 0.f, 0.f};
#pragma unroll
            for (int ks = 0; ks < 2; ++ks) {
                const bf16x8 atw = *(const LAS bf16x8*)(lds + TW_OFF + (16 * mt + c) * RSTR + (32 * ks + 8 * q) * 2), aal = *(const LAS bf16x8*)(lds + AL_OFF + (16 * mt + c) * RSTR + (32 * ks + 8 * q) * 2);
                const bf16x8 bw = *(const LAS bf16x8*)(lds + WUPT_OFF + (16 * nt + c) * RSTR + (32 * ks + 8 * q) * 2), ba = *(const LAS bf16x8*)(lds + AUPT_OFF + (16 * nt + c) * RSTR + (32 * ks + 8 * q) * 2);
                cw = MFMA32(atw, bw, cw); ca = MFMA32(aal, ba, ca); }
            float lw[4], av[4], bv[4], kv[4], rv[4], vv[4];
#pragma unroll
            for (int reg = 0; reg < 4; ++reg) { const int tok = 16 * mt + 4 * q + reg;
                const float sg = sigm(p_w0 + cw[reg]); lw[reg] = -0.6065306597126334f * LOG2E * sg;
                const float al = sigm(p_a0 + ca[reg]);
                const float rr = RAWF[(tok * 3 + 0) * 64 + ich], kr = RAWF[(tok * 3 + 1) * 64 + ich]; vv[reg] = RAWF[(tok * 3 + 2) * 64 + ich];
                const float kkn = kr * p_kk / fmaxf(sqrtf(SSQ[tok]), 1e-12f);
                const float kp = kr * (1.0f + (al - 1.0f) * p_ka);
                av[reg] = -kkn; bv[reg] = kkn * al; kv[reg] = kp; rv[reg] = rr;
                const float bs = sum16(rr * kp * p_rk); if (c == 0) __hip_atomic_fetch_add(BON + tok, bs, __ATOMIC_RELAXED, __HIP_MEMORY_SCOPE_WORKGROUP); }
            float L[4]; L[0] = lw[0]; L[1] = L[0] + lw[1]; L[2] = L[1] + lw[2]; L[3] = L[2] + lw[3];
            float pq = L[3]; { const float t1 = __shfl_up(pq, 16); if (q >= 1) pq += t1; const float t2 = __shfl_up(pq, 32); if (q >= 2) pq += t2; }
            const float excl = pq - L[3];
#pragma unroll
            for (int reg = 0; reg < 4; ++reg) { const int tok = 16 * mt + 4 * q + reg; const float Li = excl + L[reg], Lm = Li - lw[reg];
                const float eP = __builtin_amdgcn_exp2f(Li), eM = __builtin_amdgcn_exp2f(Lm), eN = __builtin_amdgcn_exp2f(-Li);
                const int off = tok * RSTR + ich * 2;
                *(LAS unsigned short*)(lds + AT_OFF + off) = (unsigned short)f2bf(av[reg] * eM);
                *(LAS unsigned short*)(lds + RT_OFF + off) = (unsigned short)f2bf(rv[reg] * eP);
                *(LAS unsigned short*)(lds + BT_OFF + off) = (unsigned short)f2bf(bv[reg] * eN);
                *(LAS unsigned short*)(lds + KT_OFF + off) = (unsigned short)f2bf(kv[reg] * eN);
                *(LAS unsigned short*)(lds + VV_OFF + off) = (unsigned short)f2bf(vv[reg]);
                if (q == 3 && reg == 3) GAM[mt * 64 + ich] = eP; }
        }
        __syncthreads();
        { const int ch = w & 3, tk0 = 16 * ch;
          const bf16x8 aA0 = *(const LAS bf16x8*)(lds + AT_OFF + (tk0 + c) * RSTR + (8 * q) * 2), aA1 = *(const LAS bf16x8*)(lds + AT_OFF + (tk0 + c) * RSTR + (32 + 8 * q) * 2);
          const f32x4 zero4 = (f32x4){0.f, 0.f, 0.f, 0.f};
          if (w < 4) {
              const bf16x8 bB0 = *(const LAS bf16x8*)(lds + BT_OFF + (tk0 + c) * RSTR + (8 * q) * 2), bB1 = *(const LAS bf16x8*)(lds + BT_OFF + (tk0 + c) * RSTR + (32 + 8 * q) * 2);
              f32x4 X = MFMA32(aA0, bB0, zero4); X = MFMA32(aA1, bB1, X);
              LAS unsigned char* xs = lds + XS_OFF + w * 512;
#pragma unroll
              for (int reg = 0; reg < 4; ++reg) *(LAS unsigned short*)(xs + (4 * q + reg) * 32 + c * 2) = (unsigned short)f2bf((c < 4 * q + reg) ? X[reg] : 0.f);
              const s16x4 aX = *(const LAS s16x4*)(xs + c * 32 + 8 * q);
              f32x4 I4;
#pragma unroll
              for (int reg = 0; reg < 4; ++reg) I4[reg] = (4 * q + reg == c) ? 1.f : 0.f;
              f32x4 Tt = I4;
#pragma unroll
              for (int it = 0; it < 15; ++it) Tt = MFMA16(aX, pack4(Tt), I4);
#pragma unroll
              for (int reg = 0; reg < 4; ++reg) *(LAS unsigned short*)(lds + TT_OFF + ch * 512 + (4 * q + reg) * 32 + c * 2) = (unsigned short)f2bf(Tt[reg]);
          } else {
              const bf16x8 aR0 = *(const LAS bf16x8*)(lds + RT_OFF + (tk0 + c) * RSTR + (8 * q) * 2), aR1 = *(const LAS bf16x8*)(lds + RT_OFF + (tk0 + c) * RSTR + (32 + 8 * q) * 2);
              const bf16x8 bB0 = *(const LAS bf16x8*)(lds + BT_OFF + (tk0 + c) * RSTR + (8 * q) * 2), bB1 = *(const LAS bf16x8*)(lds + BT_OFF + (tk0 + c) * RSTR + (32 + 8 * q) * 2);
              const bf16x8 bK0 = *(const LAS bf16x8*)(lds + KT_OFF + (tk0 + c) * RSTR + (8 * q) * 2), bK1 = *(const LAS bf16x8*)(lds + KT_OFF + (tk0 + c) * RSTR + (32 + 8 * q) * 2);
              f32x4 mk = MFMA32(aA0, bK0, zero4); mk = MFMA32(aA1, bK1, mk);
              f32x4 pb = MFMA32(aR0, bB0, zero4); pb = MFMA32(aR1, bB1, pb);
              f32x4 pk = MFMA32(aR0, bK0, zero4); pk = MFMA32(aR1, bK1, pk);
#pragma unroll
              for (int reg = 0; reg < 4; ++reg) { const int o = ch * 512 + (4 * q + reg) * 32 + c * 2; const bool lt = c < 4 * q + reg, le = c <= 4 * q + reg;
                  *(LAS unsigned short*)(lds + MK_OFF + o) = (unsigned short)f2bf(lt ? mk[reg] : 0.f);
                  *(LAS unsigned short*)(lds + PB_OFF + o) = (unsigned short)f2bf(le ? pb[reg] : 0.f);
                  *(LAS unsigned short*)(lds + PK_OFF + o) = (unsigned short)f2bf(le ? pk[reg] : 0.f); }
              if (w == 7) SSQ[lane] = 0.f;
          } }
        __syncthreads();
        if (w < 4) {
#pragma unroll 1
            for (int ch = 0; ch < 4; ++ch) { const int tk0 = 16 * ch;
                const int trow = (tk0 + 4 * q + (c >> 2)) * RSTR + (c & 3) * 8;
                s16x4 sb[4];
#pragma unroll
                for (int n = 0; n < 4; ++n) sb[n] = pack4(ST[n]);
                const s16x4 bV = vtr(lds + VV_OFF + trow + 32 * w);
                f32x4 WT = (f32x4){0.f, 0.f, 0.f, 0.f}, YT = (f32x4){0.f, 0.f, 0.f, 0.f};
#pragma unroll
                for (int n = 0; n < 4; ++n) { const s16x4 aA = *(const LAS s16x4*)(lds + AT_OFF + (tk0 + c) * RSTR + (16 * n + 4 * q) * 2), aR = *(const LAS s16x4*)(lds + RT_OFF + (tk0 + c) * RSTR + (16 * n + 4 * q) * 2);
                    WT = MFMA16(aA, sb[n], WT); YT = MFMA16(aR, sb[n], YT); }
                { const s16x4 aM = *(const LAS s16x4*)(lds + MK_OFF + ch * 512 + c * 32 + 8 * q), aPk = *(const LAS s16x4*)(lds + PK_OFF + ch * 512 + c * 32 + 8 * q);
                  WT = MFMA16(aM, bV, WT); YT = MFMA16(aPk, bV, YT); }
                const s16x4 aT = *(const LAS s16x4*)(lds + TT_OFF + ch * 512 + c * 32 + 8 * q);
                const f32x4 UT = MFMA16(aT, pack4(WT), ((f32x4){0.f, 0.f, 0.f, 0.f}));
                const s16x4 ub = pack4(UT);
                { const s16x4 aPb = *(const LAS s16x4*)(lds + PB_OFF + ch * 512 + c * 32 + 8 * q); YT = MFMA16(aPb, ub, YT); }
#pragma unroll
                for (int reg = 0; reg < 4; ++reg) Y[(tk0 + 4 * q + reg) * 64 + 16 * w + c] = YT[reg];
#pragma unroll
                for (int n = 0; n < 4; ++n) { const s16x4 aB = vtr(lds + BT_OFF + trow + 32 * n), aK = vtr(lds + KT_OFF + trow + 32 * n);
                    ST[n] = MFMA16(aB, ub, ST[n]); ST[n] = MFMA16(aK, bV, ST[n]);
                    const f32x4 gm = *(const LAS f32x4*)(GAM + ch * 64 + 16 * n + 4 * q); ST[n] = ST[n] * gm; }
            }
        }
        __syncthreads();
        { const f32x4 y0 = *(const LAS f32x4*)(Y + otok * 64 + 8 * opart), y1 = *(const LAS f32x4*)(Y + otok * 64 + 8 * opart + 4);
          const float mu = sum8(((y0[0] + y0[1]) + (y0[2] + y0[3])) + ((y1[0] + y1[1]) + (y1[2] + y1[3]))) * (1.0f / 64.0f); const f32x4 d0 = y0 - mu, d1 = y1 - mu;
          const float var = sum8(((d0[0] * d0[0] + d0[1] * d0[1]) + (d0[2] * d0[2] + d0[3] * d0[3])) + ((d1[0] * d1[0] + d1[1] * d1[1]) + (d1[2] * d1[2] + d1[3] * d1[3]))) * (1.0f / 64.0f);
          const float rs = 1.0f / sqrtf(var + GN_EPS); const float bon = BON[otok];
          const v4u vb = *(const LAS v4u*)(lds + VV_OFF + otok * RSTR + opart * 16);
          const f32x4 v0 = (f32x4){bflo(vb.x), bfhi(vb.x), bflo(vb.y), bfhi(vb.y)}, v1 = (f32x4){bflo(vb.z), bfhi(vb.z), bflo(vb.w), bfhi(vb.w)};
          const f32x4 lw0 = *(const GAS f32x4*)(F.ln_w + hc_o), lw1 = *(const GAS f32x4*)(F.ln_w + hc_o + 4), lb0 = *(const GAS f32x4*)(F.ln_b + hc_o), lb1 = *(const GAS f32x4*)(F.ln_b + hc_o + 4);
          const f32x4 o0 = d0 * rs * lw0 + lb0 + v0 * bon, o1 = d1 * rs * lw1 + lb1 + v1 * bon;
          v4u ow; ow.x = pk2(o0[0], o0[1]); ow.y = pk2(o0[2], o0[3]); ow.z = pk2(o1[0], o1[1]); ow.w = pk2(o1[2], o1[3]);
          *(GAS v4u*)(F.OR + ((size_t)b * SEQ + t0 + otok) * 512 + hc_o) = ow; }
        __syncthreads();
    }
#undef RW_LOAD
#undef PIECE
    __syncthreads();
}
}

__device__ __forceinline__ void p456_chain(Frame& F) {
        const pg8::PanelOrder S{F.vcu, 4};
        { pg8::Gemm g{F.A1, F.WTA, 2 * M, 2 * D, 512}; const pg8::PanelOrder2 S2{F.vcu}; pg8::EpiMerge2 E{F.SGA, F.SGB, F.MG};
          pg8::gemm_phase<pg8::EpiMerge2, pg8::PanelOrder2, true, true>(F.lds, g, S2, E); }
        VM_WAIT(); __syncthreads();
        if (threadIdx.x == 0) { __builtin_amdgcn_fence(__ATOMIC_ACQUIRE, "agent"); VM_WAIT(); }
        LAS float* ss = (LAS float*)(F.lds + SS_OFF);
        if (threadIdx.x < 256) ss[threadIdx.x] = 0.f;
        __syncthreads();
        { pg8::Gemm g{F.MG, F.WTO, M, D, D}; pg8::EpiOut E{F.out, ss};
          pg8::gemm_phase<pg8::EpiOut, pg8::PanelOrder, true, true>(F.lds, g, S, E); }
        VM_WAIT(); LDS_WAIT(); __syncthreads();
        if (threadIdx.x == 0) { __builtin_amdgcn_fence(__ATOMIC_ACQUIRE, "agent"); VM_WAIT(); }
        __syncthreads();
        int t2 = threadIdx.x; asm volatile("" : "+v"(t2)); const int lane2 = t2 & 63, wave2 = __builtin_amdgcn_readfirstlane(t2 >> 6);
        for (int r = wave2; r < 256; r += NWAVES) { const size_t row = (size_t)F.vcu * 256 + r; const float rstd = 1.0f / sqrtf(ss[r] * (1.0f / D) + RMS_EPS);
            float* orow = F.out + row * D; const float* xrow = F.x + row * D;
            v4u raw[2];
#pragma unroll
            for (int j = 0; j < 2; ++j) raw[j] = *((const GAS v4u*)orow + lane2 + 64 * j);
#pragma unroll
            for (int j = 0; j < 2; ++j) { const int col = 8 * lane2 + 512 * j;
                const f32x4 x0 = *(const GAS f32x4*)(xrow + col), x1 = *(const GAS f32x4*)(xrow + col + 4), g0 = *(const GAS f32x4*)(F.post_g + col), g1 = *(const GAS f32x4*)(F.post_g + col + 4);
                const f32x4 r0 = (f32x4){bflo(raw[j].x), bfhi(raw[j].x), bflo(raw[j].y), bfhi(raw[j].y)}, r1 = (f32x4){bflo(raw[j].z), bfhi(raw[j].z), bflo(raw[j].w), bfhi(raw[j].w)};
                *(GAS f32x4*)(orow + col) = x0 + r0 * rstd * g0; *(GAS f32x4*)(orow + col + 4) = x1 + r1 * rstd * g1; } }
    }

#ifndef MK_N_LAUNCHES
#define MK_N_LAUNCHES 1
#endif
constexpr int N_LAUNCHES = MK_N_LAUNCHES;
#ifndef REP_P0
#define REP_P0 1
#endif
#ifndef REP_P1
#define REP_P1 1
#endif
#ifndef REP_SCAN
#define REP_SCAN 1
#endif
#ifndef REP_P3
#define REP_P3 1
#endif
#ifndef REP_P4
#define REP_P4 1
#endif
#ifndef TSPROBE
#define TSPROBE -1
#endif
#if TSPROBE >= 0
#define TS_MARK(k) do { if (blockIdx.x == 0 && threadIdx.x == 0) __hip_atomic_store((unsigned long long*)(args.ws + 512 * 1024) + (k), (unsigned long long)__builtin_amdgcn_s_memrealtime(), __ATOMIC_RELAXED, __HIP_MEMORY_SCOPE_AGENT); } while (0)
#else
#define TS_MARK(k) do { } while (0)
#endif
constexpr int N_PHASES = 5;
struct Args { const float* in[18]; float* out; unsigned char* ws; int ph_lo, ph_hi; };
__global__ void __launch_bounds__(NWAVES * 64, 2) mk_fwd(Args args) {
    extern __shared__ __attribute__((aligned(16))) unsigned char lds[];
    Frame F;
    F.lds = (LAS unsigned char*)lds;
    F.MISC = (volatile LAS unsigned*)(F.lds + MISC_OFF);
    F.tid = threadIdx.x; F.lane = F.tid & 63; F.wave = __builtin_amdgcn_readfirstlane(F.tid >> 6);
    F.G = gridDim.x; { const int bx = blockIdx.x; F.vcu = (F.G % 8 == 0) ? (bx % 8) * (F.G / 8) + bx / 8 : bx; }
    unsigned char* ws = args.ws;
    F.ctl = (gu32*)(ws + WS_CTL);
    F.x = args.in[0]; F.pre_g = args.in[1]; F.w_in = args.in[2]; F.rel_bias = args.in[3]; F.mix = args.in[4]; F.w0 = args.in[5]; F.w_up = args.in[6]; F.a0 = args.in[7]; F.a_up = args.in[8];
    F.k_k = args.in[9]; F.k_a = args.in[10]; F.r_k = args.in[11]; F.ln_w = args.in[12]; F.ln_b = args.in[13]; F.w_upA = args.in[14]; F.w_upB = args.in[15]; F.w_out = args.in[16]; F.post_g = args.in[17];
    F.out = args.out;
    F.WT1 = (bf16*)(ws + WS_WT1); F.WTA = (bf16*)(ws + WS_WTA); F.WTB = (bf16*)(ws + WS_WTB); F.WTO = (bf16*)(ws + WS_WTO); F.LSE = (float*)(ws + WS_LSE);
    F.H = (bf16*)(ws + WS_H); F.QKV = (bf16*)(ws + WS_QKV); F.RW = (bf16*)(ws + WS_RW);
    F.SGA = (bf16*)(ws + WS_SGA); F.SGB = (bf16*)(ws + WS_SGB); F.A1 = (bf16*)(ws + WS_A1); F.A2 = (bf16*)(ws + WS_A2); F.MG = (bf16*)(ws + WS_MG);
    F.OA = (bf16*)((unsigned char*)args.out + OUT_OA); F.OR = (bf16*)((unsigned char*)args.out + OUT_OR);
    for (int u = F.tid; u < (LDS_BYTES - LDSCTL_OFF) / 4; u += NWAVES * 64) ((LAS unsigned*)(F.lds + LDSCTL_OFF))[u] = 0u;
    __syncthreads();
    XcdBarrier bar; bar.bar = (unsigned*)(F.ctl + CW_BAR); bar.x = 0; bar.st = nullptr;
    if (N_LAUNCHES == 1) bar = xcd_barrier_post((unsigned*)(F.ctl + CW_BAR), F.MISC + 8);
    const int lo = args.ph_lo, hi = args.ph_hi;
#define IN(k) (lo <= (k) && (k) < hi)
#define BOTH(k) (IN(k) && IN((k) + 1))
#define GRID_BAR() do { if (N_LAUNCHES == 1) xcd_barrier(bar); } while (0)

    TS_MARK(0);
    if (IN(0)) { for (int rep = 0; rep < REP_P0; ++rep) p0_prologue(F); if (BOTH(0)) GRID_BAR(); }

    TS_MARK(1);
    if (IN(1)) {
        pg8::Gemm g{F.H, F.WT1, M, N1, D}; pg8::StaticOrder S; S.init(M, N1, F.G, (int)blockIdx.x);
        pg8::Epi1 E{F.QKV, F.RW};
        pg8::gemm_phase<pg8::Epi1, pg8::StaticOrder, true, true>(F.lds, g, S, E);
#if REP_P1 == 2
        pg8::gemm_phase<pg8::Epi1, pg8::StaticOrder, true, true>(F.lds, g, S, E);
#endif
        if (BOTH(1)) GRID_BAR();
    }

    TS_MARK(2);
    if (IN(2)) {
        att::attn_phase(F);
        TS_MARK(3);
        rwkv::scan_phase(F);
#if REP_SCAN == 2
        rwkv::scan_phase(F);
#endif
        if (BOTH(2)) GRID_BAR();
    }

    TS_MARK(4);
    if (IN(3)) {
        pg8::Gemm g{F.H, F.WT1 + (size_t)N1 * D, M, N2, D}; pg8::StaticOrder S; S.init(M, N2, F.G, (int)blockIdx.x);
        pg8::Epi2 E{F.OA, F.OR, F.A1, F.A2, F.SGA, F.SGB};
        pg8::gemm_phase<pg8::Epi2, pg8::StaticOrder, true, true>(F.lds, g, S, E);
#if REP_P3 == 2
        pg8::gemm_phase<pg8::Epi2, pg8::StaticOrder, true, true>(F.lds, g, S, E);
#endif
        if (BOTH(3)) GRID_BAR();
    }

    TS_MARK(5);
    if (IN(4) && F.vcu < M / 256) {
        p456_chain(F);
#if REP_P4 == 2
        p456_chain(F);
#endif
    }
#if TSPROBE >= 0
    if (blockIdx.x == 0 && threadIdx.x == 0) { VM_WAIT(); const unsigned long long t6 = __builtin_amdgcn_s_memrealtime(); unsigned long long* tsb = (unsigned long long*)(args.ws + 512 * 1024);
        const unsigned long long ta = __hip_atomic_load(tsb + TSPROBE, __ATOMIC_RELAXED, __HIP_MEMORY_SCOPE_AGENT), t0 = __hip_atomic_load(tsb, __ATOMIC_RELAXED, __HIP_MEMORY_SCOPE_AGENT);
        const unsigned long long tb = (TSPROBE == 5) ? t6 : __hip_atomic_load(tsb + TSPROBE + 1, __ATOMIC_RELAXED, __HIP_MEMORY_SCOPE_AGENT);
        const float frac = (float)(tb - ta) / (float)(t6 - t0); F.out[0] += 0.25f + 0.5f * frac; }
#endif
#undef IN
#undef BOTH
#undef GRID_BAR
}

extern "C" void kernel_launch(void* const* d_in, const int* in_sizes, int n_in, void* d_out, int out_size, void* d_ws, size_t ws_size, hipStream_t stream) {
    static int grid = 0;
    if (grid == 0) {
        if (n_in != 18 || in_sizes[0] != M * D || out_size != M * D || ws_size < WS_END) { fprintf(stderr, "kernel_launch: unexpected shapes / workspace: n_in %d in0 %d out %d ws %zu (need %zu)\n", n_in, n_in > 0 ? in_sizes[0] : -1, out_size, ws_size, (size_t)WS_END); grid = -1; return; }
        int dev = 0, cus = 0, per_cu = 0;
        if (hipGetDevice(&dev) != hipSuccess || hipDeviceGetAttribute(&cus, hipDeviceAttributeMultiprocessorCount, dev) != hipSuccess) { grid = -1; return; }
        if (hipFuncSetAttribute((const void*)mk_fwd, hipFuncAttributeMaxDynamicSharedMemorySize, LDS_BYTES) != hipSuccess) { fprintf(stderr, "kernel_launch: hipFuncSetAttribute failed\n"); grid = -1; return; }
        if (hipOccupancyMaxActiveBlocksPerMultiprocessor(&per_cu, (const void*)mk_fwd, NWAVES * 64, LDS_BYTES) != hipSuccess || per_cu < 1) fprintf(stderr, "kernel_launch: occupancy query reports %d\n", per_cu);
        (void)hipGetLastError();
        grid = cus;
        if (grid != 256) fprintf(stderr, "kernel_launch: %d CUs (built for 256)\n", grid);
        fprintf(stderr, "kernel_launch: ws_size %zu, grid %d, per_cu %d\n", ws_size, grid, per_cu);
    }
    if (grid < 0) return;
    if (hipMemsetAsync((char*)d_ws + WS_CTL, 0, CTL_ZERO_BYTES, stream) != hipSuccess) return;
    Args a{};
    for (int i = 0; i < 18; ++i) a.in[i] = (const float*)d_in[i];
    a.out = (float*)d_out; a.ws = (unsigned char*)d_ws;
    for (int li = 0; li < N_LAUNCHES; ++li) {
        a.ph_lo = (N_LAUNCHES == 1) ? 0 : li; a.ph_hi = (N_LAUNCHES == 1) ? N_PHASES : li + 1;
        hipLaunchKernelGGL(mk_fwd, dim3(grid), dim3(NWAVES * 64), LDS_BYTES, stream, a);
        if (hipPeekAtLastError() != hipSuccess) { fprintf(stderr, "kernel_launch: launch %d failed\n", li); break; }
    }
}
```

```cpp
#include <hip/hip_runtime.h>
#include <cstdio>
#include <cstdint>
namespace pg8 {
#define PG8_LAS __attribute__((address_space(3)))
typedef unsigned short bf16_t;
typedef short bf16x8 __attribute__((ext_vector_type(8)));
typedef float f32x4 __attribute__((ext_vector_type(4)));
typedef unsigned u32x4 __attribute__((ext_vector_type(4)));
constexpr int BM = 256, BK = 64, HALF = 128, HTB = HALF * BK * 2  , STAGE_BYTES = 8 * HTB, NXCD = 8, WGM = 8;

__host__ __device__ __forceinline__ int lds_byte(int r, int c) { const int st = (r >> 4) * 2 + (c >> 5), rr = r & 15, cc = c & 31, ob = rr * 64 + cc * 2; return st * 1024 + (ob ^ (((ob >> 9) & 1) << 5)); }
__host__ __device__ __forceinline__ void stage_rc(int b, int& R, int& C) { const int st = b / 1024, sb = b % 1024, swz = sb ^ (((sb >> 9) & 1) << 5); R = (st >> 1) * 16 + swz / 64; C = (st & 1) * 32 + (swz % 64) / 2; }
__host__ __device__ __forceinline__ int perm32(int rho) { const int n = rho >> 4, i = rho & 15; return 8 * (i >> 2) + 4 * n + (i & 3); }

struct Unit { int pm, pn; };
struct Gemm { const bf16_t* A; const bf16_t* Bt; int M, N, K; };

struct StaticOrder {
    int nM, nN, nwg, G, c;
    __host__ __device__ void init(int M, int N, int G_, int c_) { nM = M / BM; nN = N / BM; nwg = nM * nN; G = G_; c = c_; }
    __host__ __device__ bool next(int i, Unit& u) const {
        const long L = (long)i * G + c; if (L >= nwg) return false;
        int wgid = (int)L; { const int q = nwg / NXCD, r = nwg % NXCD, xcd = wgid % NXCD, off = wgid / NXCD; wgid = (xcd < r ? xcd * (q + 1) : r * (q + 1) + (xcd - r) * q) + off; }
        const int nig = WGM * nN, gid = wgid / nig, fm = gid * WGM, gsz = (nM - fm) < WGM ? (nM - fm) : WGM;
        u.pm = fm + ((wgid % nig) % gsz); u.pn = (wgid % nig) / gsz; return true;
    }
    __device__ __forceinline__ void a_ready(const Unit&) const {}
    __device__ __forceinline__ void done(const Unit&) const {}
};

__device__ __forceinline__ unsigned cvt_pk_bf16(float lo, float hi) { unsigned r; asm volatile("v_cvt_pk_bf16_f32 %0, %1, %2" : "=v"(r) : "v"(lo), "v"(hi)); return r; }
typedef unsigned u32x4 __attribute__((ext_vector_type(4)));
typedef unsigned u32x2 __attribute__((ext_vector_type(2)));
__device__ __forceinline__ float bf_lo(unsigned w) { return __builtin_bit_cast(float, w << 16); }
__device__ __forceinline__ float bf_hi(unsigned w) { return __builtin_bit_cast(float, w & 0xffff0000u); }
__device__ __forceinline__ float sigmoid_f(float z) { return __builtin_amdgcn_rcpf(1.0f + __builtin_amdgcn_exp2f(-1.4426950408889634f * z)); }
constexpr float QSCALE = 0.125f * 1.4426950408889634f;

struct PanelOrder {
    int pm, nN;
    __device__ __forceinline__ bool next(int i, Unit& u) const { if (i >= nN) return false; u.pm = pm; u.pn = i; return true; }
    __device__ __forceinline__ void a_ready(const Unit&) const {}
    __device__ __forceinline__ void done(const Unit&) const {}
};

struct Epi1 {
    static constexpr bool PERM = true, AFTER_DRAIN = false;
    bf16_t* QKV; bf16_t* RW;
    __device__ __forceinline__ void operator()(const f32x4 (&acc)[2][2][4][2], const Unit& u, int wr, int wc, int fr, int fq) const {
        const int row0 = u.pm * BM + wr * 64 + fr;
        bf16_t* base; int ldc, colt; float sc = 1.f;
        if (u.pn < 18) { base = QKV; ldc = 4608; colt = u.pn * BM; if (u.pn < 6) sc = QSCALE; } else { base = RW; ldc = 1792; colt = (u.pn - 18) * BM; }
        const int col0 = colt + wc * 32 + 8 * fq;
#pragma unroll
        for (int ai = 0; ai < 2; ++ai)
#pragma unroll
            for (int m = 0; m < 4; ++m) { bf16_t* rowp = base + (size_t)(row0 + ai * HALF + m * 16) * ldc + col0;
#pragma unroll
                for (int bj = 0; bj < 2; ++bj) { const f32x4 v0 = acc[ai][bj][m][0] * sc, v1 = acc[ai][bj][m][1] * sc;
                    u32x4 w; w.x = cvt_pk_bf16(v0[0], v0[1]); w.y = cvt_pk_bf16(v0[2], v0[3]); w.z = cvt_pk_bf16(v1[0], v1[1]); w.w = cvt_pk_bf16(v1[2], v1[3]);
                    *(u32x4*)(rowp + bj * HALF) = w; } }
    }
};

struct Epi2 {
    static constexpr bool PERM = true, AFTER_DRAIN = false;
    const bf16_t* OA; const bf16_t* OR; bf16_t* A1; bf16_t* A2; bf16_t* SGA; bf16_t* SGB;
    __device__ __forceinline__ void operator()(const f32x4 (&acc)[2][2][4][2], const Unit& u, int wr, int wc, int fr, int fq) const {
        const int row0 = u.pm * BM + wr * 64 + fr;
        const bf16_t* mul; bf16_t* dst; int ldc, colt;
        if (u.pn < 2) { mul = OA; dst = A1; ldc = 512; colt = u.pn * BM; }
        else if (u.pn < 4) { mul = OR; dst = A2; ldc = 512; colt = (u.pn - 2) * BM; }
        else if (u.pn < 8) { mul = nullptr; dst = SGA; ldc = 1024; colt = (u.pn - 4) * BM; }
        else { mul = nullptr; dst = SGB; ldc = 1024; colt = (u.pn - 8) * BM; }
        const int col0 = colt + wc * 32 + 8 * fq;
#pragma unroll
        for (int ai = 0; ai < 2; ++ai)
#pragma unroll
            for (int m = 0; m < 4; ++m) { const size_t off = (size_t)(row0 + ai * HALF + m * 16) * ldc + col0;
#pragma unroll
                for (int bj = 0; bj < 2; ++bj) { const f32x4 z0 = acc[ai][bj][m][0], z1 = acc[ai][bj][m][1];
                    float f[8];
#pragma unroll
                    for (int e = 0; e < 4; ++e) { f[e] = sigmoid_f(z0[e]); f[4 + e] = sigmoid_f(z1[e]); }
                    if (mul) { const u32x4 o = *(const u32x4*)(mul + off + bj * HALF);
#pragma unroll
                        for (int e = 0; e < 4; ++e) { f[e] *= z0[e]; f[4 + e] *= z1[e]; }
                        f[0] *= bf_lo(o.x); f[1] *= bf_hi(o.x); f[2] *= bf_lo(o.y); f[3] *= bf_hi(o.y); f[4] *= bf_lo(o.z); f[5] *= bf_hi(o.z); f[6] *= bf_lo(o.w); f[7] *= bf_hi(o.w); }
                    u32x4 w; w.x = cvt_pk_bf16(f[0], f[1]); w.y = cvt_pk_bf16(f[2], f[3]); w.z = cvt_pk_bf16(f[4], f[5]); w.w = cvt_pk_bf16(f[6], f[7]);
                    *(u32x4*)(dst + off + bj * HALF) = w; } }
    }
};

struct PanelOrder2 {
    int pm;
    __device__ __forceinline__ bool next(int i, Unit& u) const { if (i >= 8) return false; u.pm = pm + (i >= 4 ? 256 : 0); u.pn = i; return true; }
    __device__ __forceinline__ void a_ready(const Unit&) const {}
    __device__ __forceinline__ void done(const Unit&) const {}
};
struct EpiMerge2 {
    static constexpr bool PERM = true, AFTER_DRAIN = false;
    const bf16_t* SGA; const bf16_t* SGB; bf16_t* MG;
    __device__ __forceinline__ void operator()(const f32x4 (&acc)[2][2][4][2], const Unit& u, int wr, int wc, int fr, int fq) const {
        const bool add = u.pn >= 4; const bf16_t* SG = add ? SGB : SGA;
        const int row0 = (u.pm & 255) * BM + wr * 64 + fr, col0 = (u.pn & 3) * BM + wc * 32 + 8 * fq;
#pragma unroll
        for (int ai = 0; ai < 2; ++ai)
#pragma unroll
            for (int m = 0; m < 4; ++m) { const size_t off = (size_t)(row0 + ai * HALF + m * 16) * 1024 + col0;
#pragma unroll
                for (int bj = 0; bj < 2; ++bj) { const f32x4 z0 = acc[ai][bj][m][0], z1 = acc[ai][bj][m][1];
                    const u32x4 g = *(const u32x4*)(SG + off + bj * HALF);
                    float f[8];
                    f[0] = z0[0] * bf_lo(g.x); f[1] = z0[1] * bf_hi(g.x); f[2] = z0[2] * bf_lo(g.y); f[3] = z0[3] * bf_hi(g.y);
                    f[4] = z1[0] * bf_lo(g.z); f[5] = z1[1] * bf_hi(g.z); f[6] = z1[2] * bf_lo(g.w); f[7] = z1[3] * bf_hi(g.w);
                    if (add) { const u32x4 p = *(const u32x4*)(MG + off + bj * HALF);
                        f[0] += bf_lo(p.x); f[1] += bf_hi(p.x); f[2] += bf_lo(p.y); f[3] += bf_hi(p.y); f[4] += bf_lo(p.z); f[5] += bf_hi(p.z); f[6] += bf_lo(p.w); f[7] += bf_hi(p.w); }
                    u32x4 w; w.x = cvt_pk_bf16(f[0], f[1]); w.y = cvt_pk_bf16(f[2], f[3]); w.z = cvt_pk_bf16(f[4], f[5]); w.w = cvt_pk_bf16(f[6], f[7]);
                    *(u32x4*)(MG + off + bj * HALF) = w; } }
    }
};

struct EpiOut {
    static constexpr bool PERM = true, AFTER_DRAIN = false;
    float* OUT; PG8_LAS float* ss;
    __device__ __forceinline__ void operator()(const f32x4 (&acc)[2][2][4][2], const Unit& u, int wr, int wc, int fr, int fq) const {
        const int row0 = u.pm * BM + wr * 64 + fr, col0 = u.pn * BM + wc * 32 + 8 * fq;
#pragma unroll
        for (int ai = 0; ai < 2; ++ai)
#pragma unroll
            for (int m = 0; m < 4; ++m) { bf16_t* rowp = (bf16_t*)(OUT + (size_t)(row0 + ai * HALF + m * 16) * 1024) + col0; float q = 0.f;
#pragma unroll
                for (int bj = 0; bj < 2; ++bj) { const f32x4 z0 = acc[ai][bj][m][0], z1 = acc[ai][bj][m][1];
                    q += (z0[0] * z0[0] + z0[1] * z0[1]) + (z0[2] * z0[2] + z0[3] * z0[3]) + (z1[0] * z1[0] + z1[1] * z1[1]) + (z1[2] * z1[2] + z1[3] * z1[3]);
                    u32x4 w; w.x = cvt_pk_bf16(z0[0], z0[1]); w.y = cvt_pk_bf16(z0[2], z0[3]); w.z = cvt_pk_bf16(z1[0], z1[1]); w.w = cvt_pk_bf16(z1[2], z1[3]);
                    *(u32x4*)(rowp + bj * HALF) = w; }
                q += __shfl_xor(q, 16); q += __shfl_xor(q, 32);
                if (fq == 0) __hip_atomic_fetch_add(ss + (ai * HALF + wr * 64 + m * 16 + fr), q, __ATOMIC_RELAXED, __HIP_MEMORY_SCOPE_WORKGROUP); }
    }
};

template <class Epi, class Sched, bool ALIGN_EPI = false, bool SP2 = false>
__device__ __forceinline__ void gemm_phase(PG8_LAS unsigned char* lds, const Gemm g, const Sched& S, const Epi& E) {
    const int tid = threadIdx.x, wid = __builtin_amdgcn_readfirstlane(tid >> 6), lane = tid & 63, wr = wid >> 2, wc = wid & 3, fr = lane & 15, fq = lane >> 4;
    const int K = g.K, nt = K / BK;
    unsigned voffA[2], voffB[2];
#pragma unroll
    for (int i = 0; i < 2; ++i) { int R, C; stage_rc(tid * 16 + i * 8192, R, C); const int Rb = Epi::PERM ? ((R & ~31) + perm32(R & 31)) : R;
        voffA[i] = (unsigned)(R * K + C) * 2u; voffB[i] = (unsigned)(Rb * K + C) * 2u; }
    const size_t kstep = (size_t)(BK * 2);
    const size_t hstep = (size_t)HALF * K * 2;
    const size_t tstep = 2 * hstep;
    const unsigned ldsw = (unsigned)wid * 1024u;
    const int aoff = lds_byte(wr * 64 + fr, fq * 8), boff = lds_byte(wc * 32 + fr, fq * 8);
#define PG8_SA(b, h) (((b) * 2 + (h)) * HTB)
#define PG8_SB(b, h) ((4 + (b) * 2 + (h)) * HTB)
#define PG8_STAGE(bufoff, gbase, voff) do { _Pragma("unroll") for (int _i = 0; _i < 2; ++_i) \
        __builtin_amdgcn_global_load_lds((const unsigned*)((const char*)(gbase) + (voff)[_i]), (PG8_LAS unsigned*)(lds + (bufoff) + ldsw + _i * 8192), 16, 0, 0); } while (0)
#define PG8_LDA(dst, b, h) do { _Pragma("unroll") for (int m = 0; m < 4; ++m) _Pragma("unroll") for (int k = 0; k < 2; ++k) dst[m][k] = *(const PG8_LAS bf16x8*)(lds + PG8_SA(b, h) + aoff + m * 2048 + k * 1024); } while (0)
#define PG8_LDB(dst, b, h) do { _Pragma("unroll") for (int n = 0; n < 2; ++n) _Pragma("unroll") for (int k = 0; k < 2; ++k) dst[n][k] = *(const PG8_LAS bf16x8*)(lds + PG8_SB(b, h) + boff + n * 2048 + k * 1024); } while (0)
#define PG8_MMA(ai, bj, At, Bt) do { __builtin_amdgcn_s_setprio(1); _Pragma("unroll") for (int m = 0; m < 4; ++m) _Pragma("unroll") for (int n = 0; n < 2; ++n) _Pragma("unroll") for (int k = 0; k < 2; ++k) \
        acc[ai][bj][m][n] = __builtin_amdgcn_mfma_f32_16x16x32_bf16(Bt[n][k], At[m][k], acc[ai][bj][m][n], 0, 0, 0); __builtin_amdgcn_s_setprio(0); } while (0)
#define PG8_WAIT_V(n) asm volatile("s_waitcnt vmcnt(" #n ")" ::: "memory")
#define PG8_WAIT_L(n) asm volatile("s_waitcnt lgkmcnt(" #n ")" ::: "memory")
#define PG8_BAR __builtin_amdgcn_s_barrier()
#define PG8_SCHED __builtin_amdgcn_sched_barrier(0)
    Unit cur, nxt; int ui = 0;
    if (!S.next(0, cur)) return;
    f32x4 acc[2][2][4][2];
#pragma unroll
    for (int a = 0; a < 2; ++a)
#pragma unroll
        for (int b = 0; b < 2; ++b)
#pragma unroll
            for (int m = 0; m < 4; ++m)
#pragma unroll
                for (int n = 0; n < 2; ++n) acc[a][b][m][n] = (f32x4){0.f, 0.f, 0.f, 0.f};
    bf16x8 At[4][2], B0[2][2], B1[2][2];
    const char* cA = (const char*)g.A + (size_t)cur.pm * tstep; const char* cB = (const char*)g.Bt + (size_t)cur.pn * tstep;
    S.a_ready(cur);
    if constexpr (SP2) {
        PG8_STAGE(PG8_SB(0, 0), cB, voffB); PG8_STAGE(PG8_SB(0, 1), cB + hstep, voffB); PG8_STAGE(PG8_SA(0, 0), cA, voffA); PG8_STAGE(PG8_SA(0, 1), cA + hstep, voffA);
        if (wr == 1) PG8_BAR;
        PG8_WAIT_V(2); PG8_BAR;
        PG8_STAGE(PG8_SB(1, 0), cB + kstep, voffB); PG8_STAGE(PG8_SA(1, 0), cA + kstep, voffA); PG8_STAGE(PG8_SB(1, 1), cB + hstep + kstep, voffB);
        PG8_WAIT_V(6); PG8_BAR;
    } else {
        PG8_STAGE(PG8_SB(0, 0), cB, voffB); PG8_STAGE(PG8_SA(0, 0), cA, voffA); PG8_STAGE(PG8_SB(0, 1), cB + hstep, voffB); PG8_STAGE(PG8_SA(0, 1), cA + hstep, voffA);
        if (wr == 1) PG8_BAR;
        PG8_WAIT_V(4); PG8_BAR;
        PG8_STAGE(PG8_SB(1, 0), cB + kstep, voffB); PG8_STAGE(PG8_SA(1, 0), cA + kstep, voffA); PG8_STAGE(PG8_SB(1, 1), cB + hstep + kstep, voffB);
        PG8_WAIT_V(6); PG8_BAR;
    }
    for (;;) {
        const bool has_next = S.next(ui + 1, nxt);
        const char* nA = has_next ? (const char*)g.A + (size_t)nxt.pm * tstep : cA; const char* nB = has_next ? (const char*)g.Bt + (size_t)nxt.pn * tstep : cB;
        for (int t = 0; t < nt; t += 2) {
            const bool last = (t == nt - 2);
            const char* a1 = cA + (size_t)(t + 1) * kstep;
            const char* a2 = last ? nA : cA + (size_t)(t + 2) * kstep; const char* b2 = last ? nB : cB + (size_t)(t + 2) * kstep;
            const char* a3 = a2 + kstep; const char* b3 = b2 + kstep;
            if (last && has_next) S.a_ready(nxt);
            if constexpr (SP2) {
            PG8_LDB(B0, 0, 0); PG8_LDB(B1, 0, 1); PG8_SCHED; PG8_LDA(At, 0, 0); PG8_STAGE(PG8_SA(1, 1), a1 + hstep, voffA);
            PG8_WAIT_V(8); PG8_WAIT_L(0); PG8_BAR; PG8_MMA(0, 0, At, B0); PG8_MMA(0, 1, At, B1); PG8_BAR; PG8_SCHED;
            PG8_LDA(At, 0, 1); PG8_STAGE(PG8_SB(0, 0), b2, voffB); PG8_STAGE(PG8_SB(0, 1), b2 + hstep, voffB); PG8_STAGE(PG8_SA(0, 0), a2, voffA);
            PG8_WAIT_V(8); PG8_WAIT_L(0); PG8_BAR; PG8_MMA(1, 0, At, B0); PG8_MMA(1, 1, At, B1); PG8_BAR; PG8_SCHED;
            PG8_LDB(B0, 1, 0); PG8_LDB(B1, 1, 1); PG8_SCHED; PG8_LDA(At, 1, 0); PG8_STAGE(PG8_SA(0, 1), a2 + hstep, voffA);
            PG8_WAIT_V(8); PG8_WAIT_L(0); PG8_BAR; PG8_MMA(0, 0, At, B0); PG8_MMA(0, 1, At, B1); PG8_BAR; PG8_SCHED;
            PG8_LDA(At, 1, 1); PG8_STAGE(PG8_SB(1, 0), b3, voffB); PG8_STAGE(PG8_SB(1, 1), b3 + hstep, voffB); PG8_STAGE(PG8_SA(1, 0), a3, voffA);
            PG8_WAIT_V(8); PG8_WAIT_L(0); PG8_BAR; PG8_MMA(1, 0, At, B0); PG8_MMA(1, 1, At, B1); PG8_BAR; PG8_SCHED;
            } else {
            PG8_LDB(B0, 0, 0); PG8_SCHED; PG8_LDA(At, 0, 0); PG8_STAGE(PG8_SA(1, 1), a1 + hstep, voffA);
            PG8_WAIT_L(8); PG8_BAR; PG8_WAIT_L(0); PG8_MMA(0, 0, At, B0); PG8_BAR; PG8_SCHED;
            PG8_LDB(B1, 0, 1); PG8_STAGE(PG8_SB(0, 0), b2, voffB);
            PG8_BAR; PG8_WAIT_L(0); PG8_MMA(0, 1, At, B1); PG8_BAR;
            PG8_LDA(At, 0, 1); PG8_STAGE(PG8_SA(0, 0), a2, voffA);
            PG8_BAR; PG8_WAIT_L(0); PG8_MMA(1, 0, At, B0); PG8_BAR; PG8_SCHED;
            PG8_STAGE(PG8_SB(0, 1), b2 + hstep, voffB);
            PG8_WAIT_V(6); PG8_BAR; PG8_MMA(1, 1, At, B1); PG8_BAR;
            PG8_LDB(B0, 1, 0); PG8_SCHED; PG8_LDA(At, 1, 0); PG8_STAGE(PG8_SA(0, 1), a2 + hstep, voffA);
            PG8_WAIT_L(8); PG8_BAR; PG8_WAIT_L(0); PG8_MMA(0, 0, At, B0); PG8_BAR; PG8_SCHED;
            PG8_LDB(B1, 1, 1); PG8_STAGE(PG8_SB(1, 0), b3, voffB);
            PG8_BAR; PG8_WAIT_L(0); PG8_MMA(0, 1, At, B1); PG8_BAR;
            PG8_LDA(At, 1, 1); PG8_STAGE(PG8_SA(1, 0), a3, voffA);
            PG8_BAR; PG8_WAIT_L(0); PG8_MMA(1, 0, At, B0); PG8_BAR; PG8_SCHED;
            PG8_STAGE(PG8_SB(1, 1), b3 + hstep, voffB);
            PG8_WAIT_V(6); PG8_BAR; PG8_MMA(1, 1, At, B1); PG8_BAR;
            }
        }
        if constexpr (ALIGN_EPI) { if (wr == 0) PG8_BAR; }
        if constexpr (!Epi::AFTER_DRAIN) { E(acc, cur, wr, wc, fr, fq); S.done(cur); }
        if (!has_next) break;
#pragma unroll
        for (int a = 0; a < 2; ++a)
#pragma unroll
            for (int b = 0; b < 2; ++b)
#pragma unroll
                for (int m = 0; m < 4; ++m)
#pragma unroll
                    for (int n = 0; n < 2; ++n) acc[a][b][m][n] = (f32x4){0.f, 0.f, 0.f, 0.f};
        cur = nxt; cA = nA; cB = nB; ++ui;
        if constexpr (ALIGN_EPI) { if (wr == 1) PG8_BAR; }
    }
    PG8_WAIT_V(0);
    if constexpr (!ALIGN_EPI) { if (wr == 0) PG8_BAR; }
    PG8_BAR;
    if constexpr (Epi::AFTER_DRAIN) { E.fused(acc, cur, wr, wc, fr, fq, lds, wid, lane); S.done(cur); }
#undef PG8_SA
#undef PG8_SB
#undef PG8_STAGE
#undef PG8_LDA
#undef PG8_LDB
#undef PG8_MMA
#undef PG8_WAIT_V
#undef PG8_WAIT_L
#undef PG8_BAR
#undef PG8_SCHED
}
}

constexpr int NWAVES = 8;
constexpr int BATCH = 32, SEQ = 2048, D = 1024, M = BATCH * SEQ;
constexpr int NQKV = 4608, RW_LD = 1792, LDW_IN = 9344;
constexpr int N1 = 6400, N2 = 3072, WT1_ROWS = N1 + N2;
constexpr int OFF_ATTN_GATE = 4608, OFF_RWKV = 5120, OFF_RWKV_GATE = 6784, OFF_MERGE = 7296;
constexpr float RMS_EPS = 1e-6f, GN_EPS = 64e-5f;
constexpr float LOG2E = 1.4426950408889634f;

constexpr size_t MiB = 1u << 20;
constexpr size_t WS_CTL = 0, CTL_ZERO_BYTES = 1 * MiB;
constexpr size_t WS_WT1 = 2 * MiB, WS_WTA = 22 * MiB, WS_WTB = 23 * MiB, WS_WTO = 24 * MiB, WS_LSE = 26 * MiB;
constexpr size_t WS_H = 32 * MiB, WS_QKV = 160 * MiB, WS_RW = 736 * MiB, WS_END = 960 * MiB;
constexpr size_t WS_SGA = 160 * MiB, WS_SGB = 288 * MiB, WS_A1 = 416 * MiB, WS_A2 = 480 * MiB, WS_MG = 544 * MiB;
static_assert(WS_WT1 + (size_t)WT1_ROWS * D * 2 <= WS_WTA && WS_LSE + (size_t)3 * M * 8 * 4 <= WS_H && WS_H + (size_t)M * D * 2 <= WS_QKV && WS_QKV + (size_t)M * NQKV * 2 <= WS_RW && WS_RW + (size_t)M * RW_LD * 2 <= WS_END && WS_MG + (size_t)M * D * 2 <= WS_RW, "d_ws map");
constexpr size_t OUT_OA = 0, OUT_OR = 64 * MiB;
constexpr int CW_BAR = 4096;

constexpr int RING_BYTES = 131072;
constexpr int LDS_BYTES = 163840;
constexpr int LDSCTL_OFF = LDS_BYTES - 2048, MISC_OFF = LDSCTL_OFF + 320, SS_OFF = MISC_OFF + 128;
static_assert(SS_OFF + 1024 <= LDS_BYTES, "LDS map");

#define GAS __attribute__((address_space(1)))
#define LAS __attribute__((address_space(3)))
typedef unsigned short bf16;
typedef unsigned v4u __attribute__((ext_vector_type(4)));
typedef unsigned v2u __attribute__((ext_vector_type(2)));
typedef float f32x4 __attribute__((ext_vector_type(4)));
typedef short bf16x8 __attribute__((ext_vector_type(8)));
typedef short s16x4 __attribute__((ext_vector_type(4)));
typedef GAS unsigned gu32;
#define LDS_WAIT() asm volatile("s_waitcnt lgkmcnt(0)" ::: "memory")
#define VM_WAIT() asm volatile("s_waitcnt vmcnt(0)" ::: "memory")
__device__ __forceinline__ unsigned f2bf(float f) { unsigned u = __builtin_bit_cast(unsigned, f); return (u + 0x7fffu + ((u >> 16) & 1u)) >> 16; }
__device__ __forceinline__ unsigned pk2(float lo, float hi) { return f2bf(lo) | (f2bf(hi) << 16); }
__device__ __forceinline__ float bflo(unsigned w) { return __builtin_bit_cast(float, w << 16); }
__device__ __forceinline__ float bfhi(unsigned w) { return __builtin_bit_cast(float, w & 0xffff0000u); }
template <int CTRL> __device__ __forceinline__ float dpp_f(float v) { return __builtin_bit_cast(float, __builtin_amdgcn_update_dpp(0, __builtin_bit_cast(int, v), CTRL, 0xF, 0xF, false)); }
__device__ __forceinline__ float sum4(float v) { v += dpp_f<0xB1>(v); v += dpp_f<0x4E>(v); return v; }
__device__ __forceinline__ float sum8(float v) { v = sum4(v); v += dpp_f<0x141>(v); return v; }
__device__ __forceinline__ float sum16(float v) { v = sum8(v); v += dpp_f<0x140>(v); return v; }
__device__ __forceinline__ float max16(float v) { v = fmaxf(v, dpp_f<0xB1>(v)); v = fmaxf(v, dpp_f<0x4E>(v)); v = fmaxf(v, dpp_f<0x141>(v)); v = fmaxf(v, dpp_f<0x140>(v)); return v; }
__device__ __forceinline__ float sigm(float z) { return __builtin_amdgcn_rcpf(1.0f + __builtin_amdgcn_exp2f(-LOG2E * z)); }
#define XB_TMO      128
#define XB_XCNT(j)  (256  + 64 * (j))
#define XB_XSUB(j)  (1280 + 64 * (j))
#define XB_XGEN(j)  (2304 + 64 * (j))
#define XB_TOP      3328
#define XB_TOPGEN   3392
#define XCD_BAR_WORDS 3456
#define XB_SPIN_CAP (1u << 18)

__device__ __forceinline__ unsigned xb_ld(unsigned* p)              { return __hip_atomic_load(p, __ATOMIC_RELAXED, __HIP_MEMORY_SCOPE_AGENT); }
__device__ __forceinline__ unsigned xb_add(unsigned* p, unsigned v) { return __hip_atomic_fetch_add(p, v, __ATOMIC_RELAXED, __HIP_MEMORY_SCOPE_AGENT); }
__device__ __forceinline__ unsigned xb_xcc_id() { return (unsigned)__builtin_amdgcn_s_getreg((3 << 11) | 20) & 0xFu; }
#define XB_SPIN(cond, bar) do { unsigned _sp = 0; while (cond) { __builtin_amdgcn_s_sleep(1); \
    if ((++_sp & 255u) == 0u) { if (xb_ld(&(bar)[XB_TMO])) break; if (_sp > XB_SPIN_CAP) { atomicAdd(&(bar)[XB_TMO], 1u); break; } } } } while (0)

struct XcdBarrier {
    unsigned* bar; unsigned x;
    volatile LAS unsigned* st;
};

__device__ __forceinline__ XcdBarrier xcd_barrier_post(unsigned* bar, volatile LAS unsigned* st) {
    XcdBarrier b; b.bar = bar; b.x = xb_xcc_id(); b.st = st;
    if (threadIdx.x == 0) (void)xb_add(&bar[XB_XCNT(b.x)], 1u);
    return b;
}
__device__ __forceinline__ void xcd_barrier_complete(unsigned* bar, unsigned x, unsigned& nloc, unsigned& nx) {
    const unsigned G = gridDim.x * gridDim.y * gridDim.z;
    unsigned sum, cnt, mine, sp = 0u;
    for (;;) {
        sum = 0u; cnt = 0u; mine = 0u;
#pragma unroll
        for (unsigned j = 0; j < 16; ++j) { const unsigned c = xb_ld(&bar[XB_XCNT(j)]); sum += c; cnt += (c > 0u) ? 1u : 0u; mine = (j == x) ? c : mine; }
        if (sum == G) break;
        __builtin_amdgcn_s_sleep(1);
        if ((++sp & 255u) == 0u) { if (xb_ld(&bar[XB_TMO])) break; if (sp > XB_SPIN_CAP) { atomicAdd(&bar[XB_TMO], 1u); break; } }
    }
    nloc = mine > 0u ? mine : 1u; nx = cnt > 0u ? cnt : 1u;
}

__device__ __forceinline__ void xcd_barrier(const XcdBarrier& b) {
    asm volatile("s_waitcnt vmcnt(0)" ::: "memory");
    __syncthreads();
    if (threadIdx.x == 0) {
        unsigned* bar = b.bar;
        __builtin_amdgcn_s_waitcnt(0);
        unsigned nloc = b.st[0], nx = b.st[1];
        if (nloc == 0u) { xcd_barrier_complete(bar, b.x, nloc, nx); b.st[0] = nloc; b.st[1] = nx; }
        const unsigned old = xb_add(&bar[XB_XSUB(b.x)], 1u);
        const unsigned gen = old / nloc;
        if (old + 1u == (gen + 1u) * nloc) {
            __builtin_amdgcn_fence(__ATOMIC_RELEASE, "agent");
            asm volatile("s_waitcnt vmcnt(0)" ::: "memory");
            const unsigned og = xb_add(&bar[XB_TOP], 1u);
            const unsigned tg = og / nx;
            if (og + 1u == (tg + 1u) * nx) xb_add(&bar[XB_TOPGEN], 1u);
            else XB_SPIN(xb_ld(&bar[XB_TOPGEN]) == tg, bar);
            __builtin_amdgcn_fence(__ATOMIC_ACQUIRE, "agent");
            xb_add(&bar[XB_XGEN(b.x)], 1u);
            asm volatile("s_waitcnt vmcnt(0)" ::: "memory");
        } else {
            XB_SPIN(xb_ld(&bar[XB_XGEN(b.x)]) == gen, bar);
            __builtin_amdgcn_fence(__ATOMIC_ACQUIRE, "agent");
            asm volatile("s_waitcnt vmcnt(0)" ::: "memory");
        }
    }
    __syncthreads();
}

struct Frame {
    LAS unsigned char* lds;
    volatile LAS unsigned* MISC;
    gu32* ctl;
    int tid, lane, wave;
    int vcu, G;
    const float* x; float* out;
    const float *pre_g, *w_in, *rel_bias, *mix, *w0, *w_up, *a0, *a_up, *k_k, *k_a, *r_k, *ln_w, *ln_b, *w_upA, *w_upB, *w_out, *post_g;
    bf16 *WT1, *WTA, *WTB, *WTO, *H, *QKV, *RW, *SGA, *SGB, *A1, *A2, *MG, *OA, *OR;
    float* LSE;
};

__device__ __forceinline__ float wave_sum(float v) {
#pragma unroll
    for (int o = 1; o < 64; o <<= 1) v += __shfl_xor(v, o);
    return v;
}
__device__ __forceinline__ void p0_transpose_item(const float* W, int K, int ldw, int c0, int nblk, bf16* WT, int row_off, LAS float* scr, int item, int lane) {
    const int kb = item / nblk, nb = item % nblk, k0 = 64 * kb, n0 = 32 * nb;
#pragma unroll 8
    for (int i = 0; i < 32; ++i) { const int kk = 2 * i + (lane >> 5); scr[kk * 33 + (lane & 31)] = W[(size_t)(k0 + kk) * ldw + c0 + n0 + (lane & 31)]; }
    LDS_WAIT(); asm volatile("" ::: "memory");
    const int c = lane & 7;
#pragma unroll
    for (int j = 0; j < 4; ++j) { const int n = (lane >> 3) + 8 * j; const LAS float* s = scr + (8 * c) * 33 + n;
        v4u o; o.x = pk2(s[0 * 33], s[1 * 33]); o.y = pk2(s[2 * 33], s[3 * 33]); o.z = pk2(s[4 * 33], s[5 * 33]); o.w = pk2(s[6 * 33], s[7 * 33]);
        *(GAS v4u*)(WT + (size_t)(row_off + n0 + n) * K + k0 + 8 * c) = o; }
    LDS_WAIT(); asm volatile("" ::: "memory");
}
__device__ __forceinline__ void rms_row_to_bf16(Frame& F, const float* xrow, bf16* orow) {
    const GAS f32x4* xr = (const GAS f32x4*)xrow + F.lane; const GAS f32x4* gr = (const GAS f32x4*)F.pre_g + F.lane;
    f32x4 v[4]; float s = 0.f;
#pragma unroll
    for (int j = 0; j < 4; ++j) { v[j] = xr[64 * j]; s += (v[j].x * v[j].x + v[j].y * v[j].y) + (v[j].z * v[j].z + v[j].w * v[j].w); }
    const float rstd = 1.f / sqrtf(wave_sum(s) * (1.f / D) + RMS_EPS);
    GAS unsigned long long* o8 = (GAS unsigned long long*)orow + F.lane;
#pragma unroll
    for (int j = 0; j < 4; ++j) { const f32x4 g = gr[64 * j]; const f32x4 y = v[j] * rstd * g;
        o8[64 * j] = (unsigned long long)pk2(y.x, y.y) | ((unsigned long long)pk2(y.z, y.w) << 32); }
}
__device__ __forceinline__ void p0_prologue(Frame& F) {
    LAS float* scr = (LAS float*)(F.lds + F.wave * 16384);
    const int gw = F.vcu * NWAVES + F.wave, NGW = F.G * NWAVES;
    constexpr int I1 = 16 * 144, I2 = 16 * 52, I4 = 16 * 16, I5 = 16 * 16, I6 = 16 * 64, I7 = 8 * 32, I8 = 8 * 32, I9 = 16 * 32;
    constexpr int NITEMS = I1 + I2 + I4 + I5 + I6 + I7 + I8 + I9;
    for (int it = gw; it < NITEMS; it += NGW) {
        int r = it;
        if (r < I1) { p0_transpose_item(F.w_in, D, LDW_IN, 0, 144, F.WT1, 0, scr, r, F.lane); continue; } r -= I1;
        if (r < I2) { p0_transpose_item(F.w_in, D, LDW_IN, OFF_RWKV, 52, F.WT1, 4608, scr, r, F.lane); continue; } r -= I2;
        if (r < I4) { p0_transpose_item(F.w_in, D, LDW_IN, OFF_ATTN_GATE, 16, F.WT1, N1, scr, r, F.lane); continue; } r -= I4;
        if (r < I5) { p0_transpose_item(F.w_in, D, LDW_IN, OFF_RWKV_GATE, 16, F.WT1, N1 + 512, scr, r, F.lane); continue; } r -= I5;
        if (r < I6) { p0_transpose_item(F.w_in, D, LDW_IN, OFF_MERGE, 64, F.WT1, N1 + 1024, scr, r, F.lane); continue; } r -= I6;
        if (r < I7) { p0_transpose_item(F.w_upA, 512, D, 0, 32, F.WTA, 0, scr, r, F.lane); continue; } r -= I7;
        if (r < I8) { p0_transpose_item(F.w_upB, 512, D, 0, 32, F.WTB, 0, scr, r, F.lane); continue; } r -= I8;
        p0_transpose_item(F.w_out, D, D, 0, 32, F.WTO, 0, scr, r, F.lane);
    }
    { const int gt = F.vcu * (NWAVES * 64) + F.tid, NT = F.G * NWAVES * 64;
      for (int i = gt; i < 16384; i += NT) *((GAS v4u*)(F.WT1 + (size_t)6272 * D) + i) = (v4u){0u, 0u, 0u, 0u}; }
    for (int m = gw; m < M; m += NGW) rms_row_to_bf16(F, F.x + (size_t)m * D, F.H + (size_t)m * D);
}

namespace att {
constexpr int KSTR = 144;
constexpr int HALF_B = 128 * KSTR;
constexpr int KS_OFF = 0, VS_OFF = 3 * HALF_B, OST_OFF = 6 * HALF_B, OST_WAVE = 16 * KSTR, LST_OFF = OST_OFF + 8 * OST_WAVE, BIAS_OFF = LST_OFF + 8 * 64, END_OFF = BIAS_OFF + 3 * 544;
static_assert(END_OFF <= LDSCTL_OFF, "attention LDS");
typedef short v4i16_t __attribute__((ext_vector_type(4)));
typedef float f32x2_t __attribute__((ext_vector_type(2)));
typedef __bf16 bf16x2_t __attribute__((ext_vector_type(2)));
__device__ __forceinline__ s16x4 vtr(LAS const unsigned char* p) { return __builtin_bit_cast(s16x4, __builtin_amdgcn_ds_read_tr16_b64_v4i16((LAS v4i16_t*)p)); }
__device__ __forceinline__ unsigned cvt2(float lo, float hi) { f32x2_t v = {lo, hi}; bf16x2_t b = __builtin_convertvector(v, bf16x2_t); return __builtin_bit_cast(unsigned, b); }
__device__ __forceinline__ int t5_bucket(int d) {
    if (d < 16) return d;
    int b = 16;
    b += (d >= 22); b += (d >= 30); b += (d >= 40); b += (d >= 54); b += (d >= 73); b += (d >= 99); b += (d >= 134); b += (d >= 182);
    b += (d >= 246); b += (d >= 332); b += (d >= 450); b += (d >= 609); b += (d >= 825); b += (d >= 1117); b += (d >= 1513);
    return b;
}
__device__ __forceinline__ void blk_decode(int i, int& g, int& dil, int& r, int& n) {
    if (i < 16) { g = 0; dil = 1; r = 0; n = i; } else if (i < 32) { g = 1; dil = 4; r = (i - 16) >> 2; n = (i - 16) & 3; } else { g = 2; dil = 16; r = i - 32; n = 0; }
}

__device__ __forceinline__ void attn_phase(Frame& F) {
    LAS unsigned char* lds = F.lds;
    const int tid = F.tid, lane = F.lane, w = F.wave, c = lane & 15, q = lane >> 4;
    const int b = F.vcu >> 3, h = F.vcu & 7;
    if (F.vcu >= BATCH * 8) return;
    const float NEG_INF = -__builtin_inff();
    __syncthreads();
    for (int i = tid; i < 3 * 129; i += NWAVES * 64) { const int g = i / 129, rel = i % 129, dil = (g == 0) ? 1 : (g == 1) ? 4 : 16;
        ((LAS float*)(lds + BIAS_OFF + g * 544))[rel] = F.rel_bias[t5_bucket(rel * dil) * 24 + g * 8 + h] * LOG2E; }
    for (int i = tid; i < 6 * HALF_B / 16; i += NWAVES * 64) *(LAS v4u*)(lds + i * 16) = (v4u){0u, 0u, 0u, 0u};
    const bf16* Qb = F.QKV + (size_t)b * SEQ * NQKV + h * 64;
    LAS unsigned char* OSTw = lds + OST_OFF + w * OST_WAVE;
    LAS float* LSTw = (LAS float*)(lds + LST_OFF + w * 64);
    const int srow0 = tid >> 3, sch = tid & 7;
    v4u kreg[2], vreg[2]; bf16x8 aq[2];
#define ATT_LOAD(i) do { int g_, dil_, r_, n_; blk_decode((i), g_, dil_, r_, n_); const bf16* Qg_ = Qb + g_ * 512; \
        _Pragma("unroll") for (int it = 0; it < 2; ++it) { const bf16* p_ = Qg_ + (size_t)((n_ * 128 + srow0 + 64 * it) * dil_ + r_) * NQKV + sch * 8; kreg[it] = *(const GAS v4u*)(p_ + 1536); vreg[it] = *(const GAS v4u*)(p_ + 3072); } \
        { const bf16* qp_ = Qg_ + (size_t)((n_ * 128 + 16 * w + c) * dil_ + r_) * NQKV + 8 * q; aq[0] = *(const GAS bf16x8*)(qp_); aq[1] = *(const GAS bf16x8*)(qp_ + 32); } } while (0)
#define ATT_STORE(slot) do { _Pragma("unroll") for (int it = 0; it < 2; ++it) { const int o_ = (slot) * HALF_B + (srow0 + 64 * it) * KSTR + sch * 16; *(LAS v4u*)(lds + KS_OFF + o_) = kreg[it]; *(LAS v4u*)(lds + VS_OFF + o_) = vreg[it]; } } while (0)
    ATT_LOAD(0);
    __syncthreads();
    ATT_STORE(0);
    bf16x8 aqc[2] = {aq[0], aq[1]};
    __syncthreads();
    float bl[9][4];
    int gprev = -1;
#pragma unroll 1
    for (int i = 0; i < 48; ++i) {
        int g, dil, r, n; blk_decode(i, g, dil, r, n);
        const int cur = i % 3, prv = (i + 2) % 3;
        if (i + 1 < 48) ATT_LOAD(i + 1);
        if (g != gprev) { gprev = g; const LAS float* bias2 = (const LAS float*)(lds + BIAS_OFF + g * 544);
#pragma unroll
            for (int n16 = 0; n16 < 9; ++n16)
#pragma unroll
                for (int reg = 0; reg < 4; ++reg) { const int rel = 128 + c - 16 * n16 - 4 * q - reg; const int rc = rel < 0 ? 0 : (rel > 128 ? 128 : rel);
                    const float bv = bias2[rc]; bl[n16][reg] = (rel >= 0 && rel <= 128) ? bv : NEG_INF; } }
        f32x4 s[9]; float mx = NEG_INF;
#pragma unroll
        for (int n16 = 0; n16 < 9; ++n16) { const int kpos0 = 16 * w + 16 * n16; const int rowb = ((kpos0 >= 128) ? cur : prv) * 128 + (kpos0 & 127);
            f32x4 a = (f32x4){0.f, 0.f, 0.f, 0.f};
#pragma unroll
            for (int ks = 0; ks < 2; ++ks) { const bf16x8 kf = *(const LAS bf16x8*)(lds + KS_OFF + (rowb + c) * KSTR + (32 * ks + 8 * q) * 2);
                a = __builtin_amdgcn_mfma_f32_16x16x32_bf16(kf, aqc[ks], a, 0, 0, 0); }
            const bool ok = (n > 0) || (kpos0 >= 128);
#pragma unroll
            for (int reg = 0; reg < 4; ++reg) { const float v = ok ? a[reg] + bl[n16][reg] : NEG_INF; a[reg] = v; mx = fmaxf(mx, v); }
            s[n16] = a; }
        mx = fmaxf(mx, __shfl_xor(mx, 16)); mx = fmaxf(mx, __shfl_xor(mx, 32));
        float ls = 0.f; s16x4 pb[9];
#pragma unroll
        for (int n16 = 0; n16 < 9; ++n16) { const float p0 = __builtin_amdgcn_exp2f(s[n16][0] - mx), p1 = __builtin_amdgcn_exp2f(s[n16][1] - mx), p2 = __builtin_amdgcn_exp2f(s[n16][2] - mx), p3 = __builtin_amdgcn_exp2f(s[n16][3] - mx);
            ls += (p0 + p1) + (p2 + p3); v2u pk; pk.x = cvt2(p0, p1); pk.y = cvt2(p2, p3); pb[n16] = __builtin_bit_cast(s16x4, pk); }
        ls += __shfl_xor(ls, 16); ls += __shfl_xor(ls, 32);
        f32x4 o[4];
#pragma unroll
        for (int nd = 0; nd < 4; ++nd) o[nd] = (f32x4){0.f, 0.f, 0.f, 0.f};
#pragma unroll
        for (int n16 = 0; n16 < 9; ++n16) { const int kpos0 = 16 * w + 16 * n16; const int rowb = ((kpos0 >= 128) ? cur : prv) * 128 + (kpos0 & 127);
            LAS const unsigned char* vb = lds + VS_OFF + (rowb + 4 * q + (c >> 2)) * KSTR + (c & 3) * 8;
#pragma unroll
            for (int nd = 0; nd < 4; ++nd) o[nd] = __builtin_amdgcn_mfma_f32_16x16x16bf16_1k(pb[n16], vtr(vb + nd * 32), o[nd], 0, 0, 0); }
        if (q == 0) LSTw[c] = ls;
        const f32x4 l4 = *(const LAS f32x4*)(LSTw + 4 * q);
#pragma unroll
        for (int reg = 0; reg < 4; ++reg) { const float inv = __builtin_amdgcn_rcpf(l4[reg]);
#pragma unroll
            for (int nd = 0; nd < 4; ++nd) *(LAS unsigned short*)(OSTw + (4 * q + reg) * KSTR + (16 * nd + c) * 2) = (unsigned short)cvt2(o[nd][reg] * inv, 0.f); }
        const bf16* Qg = Qb + g * 512;
#pragma unroll
        for (int it = 0; it < 2; ++it) { const int id = lane + 64 * it, row = id >> 3, ch = id & 7;
            const v4u val = *(const LAS v4u*)(OSTw + row * KSTR + ch * 16);
            *(GAS v4u*)(Qg + (size_t)((n * 128 + 16 * w + row) * dil + r) * NQKV + ch * 8) = val; }
        if (q == 0) F.LSE[((size_t)g * M + (size_t)b * SEQ + (size_t)((n * 128 + 16 * w + c) * dil + r)) * 8 + h] = mx + __builtin_amdgcn_logf(ls);
        if (i + 1 < 48) { ATT_STORE((i + 1) % 3); aqc[0] = aq[0]; aqc[1] = aq[1]; }
        __syncthreads();
    }
#undef ATT_LOAD
#undef ATT_STORE
    VM_WAIT(); __syncthreads();
    if (tid == 0) { __builtin_amdgcn_fence(__ATOMIC_ACQUIRE, "agent"); VM_WAIT(); }
    __syncthreads();
    for (int p = tid; p < SEQ * 8; p += NWAVES * 64) { const int t = p >> 3, ch = p & 7; const size_t row = (size_t)b * SEQ + t;
        float l0 = F.LSE[((size_t)0 * M + row) * 8 + h], l1 = F.LSE[((size_t)1 * M + row) * 8 + h], l2 = F.LSE[((size_t)2 * M + row) * 8 + h];
        const float mm = fmaxf(l0, fmaxf(l1, l2)); float w0 = __builtin_amdgcn_exp2f(l0 - mm), w1 = __builtin_amdgcn_exp2f(l1 - mm), w2 = __builtin_amdgcn_exp2f(l2 - mm);
        const float wi = __builtin_amdgcn_rcpf(w0 + w1 + w2); w0 *= wi; w1 *= wi; w2 *= wi;
        const bf16* qp = F.QKV + row * NQKV + h * 64 + ch * 8;
        const v4u a = *(const GAS v4u*)(qp), bb = *(const GAS v4u*)(qp + 512), cc = *(const GAS v4u*)(qp + 1024);
        v4u o;
        o.x = pk2(w0 * bflo(a.x) + w1 * bflo(bb.x) + w2 * bflo(cc.x), w0 * bfhi(a.x) + w1 * bfhi(bb.x) + w2 * bfhi(cc.x));
        o.y = pk2(w0 * bflo(a.y) + w1 * bflo(bb.y) + w2 * bflo(cc.y), w0 * bfhi(a.y) + w1 * bfhi(bb.y) + w2 * bfhi(cc.y));
        o.z = pk2(w0 * bflo(a.z) + w1 * bflo(bb.z) + w2 * bflo(cc.z), w0 * bfhi(a.z) + w1 * bfhi(bb.z) + w2 * bfhi(cc.z));
        o.w = pk2(w0 * bflo(a.w) + w1 * bflo(bb.w) + w2 * bflo(cc.w), w0 * bfhi(a.w) + w1 * bfhi(bb.w) + w2 * bfhi(cc.w));
        *(GAS v4u*)(F.OA + row * 512 + h * 64 + ch * 8) = o; }
    __syncthreads();
}
}

namespace rwkv {
constexpr int TC = 64, RSTR = 144;
constexpr int WUPT_OFF = 0, AUPT_OFF = 9216, TW_OFF = 18432, AL_OFF = 27648, RB_OFF = 36864, Y_OFF = 64512;
constexpr int AT_OFF = 80896, RT_OFF = 90112, BT_OFF = 99328, KT_OFF = 108544, VV_OFF = 117760;
constexpr int MK_OFF = 126976, PB_OFF = 129024, PK_OFF = 131072, TT_OFF = 133120, GAM_OFF = 135168, XS_OFF = 136192, SSQ_OFF = 140288, CONST_OFF = 140544, END_OFF = CONST_OFF + 2304;
static_assert(END_OFF <= LDSCTL_OFF, "scan LDS");
typedef short v4i16_t __attribute__((ext_vector_type(4)));
typedef float f32x2_t __attribute__((ext_vector_type(2)));
typedef __bf16 bf16x2_t __attribute__((ext_vector_type(2)));
__device__ __forceinline__ s16x4 vtr(LAS const unsigned char* p) { return __builtin_bit_cast(s16x4, __builtin_amdgcn_ds_read_tr16_b64_v4i16((LAS v4i16_t*)p)); }
__device__ __forceinline__ unsigned cvt2(float lo, float hi) { f32x2_t v = {lo, hi}; bf16x2_t b = __builtin_convertvector(v, bf16x2_t); return __builtin_bit_cast(unsigned, b); }
__device__ __forceinline__ s16x4 pack4(const f32x4& x) { v2u p; p.x = cvt2(x[0], x[1]); p.y = cvt2(x[2], x[3]); return __builtin_bit_cast(s16x4, p); }
#define MFMA16(a, b, c) __builtin_amdgcn_mfma_f32_16x16x16bf16_1k((a), (b), (c), 0, 0, 0)
#define MFMA32(a, b, c) __builtin_amdgcn_mfma_f32_16x16x32_bf16((a), (b), (c), 0, 0, 0)

__device__ __forceinline__ void scan_phase(Frame& F) {
    LAS unsigned char* lds = F.lds;
    const int tid = F.tid, lane = F.lane, w = F.wave, c = lane & 15, q = lane >> 4;
    const int b = F.vcu >> 3, h = F.vcu & 7;
    if (F.vcu >= BATCH * 8) return;
    __syncthreads();
    for (int e = tid; e < 64 * 64; e += NWAVES * 64) { const int j = e >> 6, i = e & 63;
        *(LAS unsigned short*)(lds + WUPT_OFF + i * RSTR + j * 2) = (unsigned short)f2bf(F.w_up[j * 512 + h * 64 + i]);
        *(LAS unsigned short*)(lds + AUPT_OFF + i * RSTR + j * 2) = (unsigned short)f2bf(F.a_up[j * 512 + h * 64 + i]); }
    LAS float* Y = (LAS float*)(lds + Y_OFF);
    LAS float* GAM = (LAS float*)(lds + GAM_OFF);
    LAS float* SSQ = (LAS float*)(lds + SSQ_OFF);
    LAS float* CST = (LAS float*)(lds + CONST_OFF);
    if (tid < 64) SSQ[tid] = 0.f;
    if (tid < 320) { const int run = tid >> 6, i = tid & 63; CST[tid] = F.mix[(run < 3 ? run * 512 + h * 64 : (run == 3 ? 1536 : 1600)) + i]; }
    else if (tid < 384) CST[tid] = F.k_k[h * 64 + (tid - 320)];
    else if (tid < 448) CST[tid] = F.ln_w[h * 64 + (tid - 384)];
    else CST[tid] = F.ln_b[h * 64 + (tid - 448)];
    if (tid < 64) CST[512 + tid] = F.r_k[h * 64 + tid];
    const bf16* RWb = F.RW + (size_t)b * SEQ * RW_LD;
    v4u cur[5], prv[5];
#define PIECE(it) const int p_ = tid + 512 * (it), tok_ = p_ / 40, rem_ = p_ % 40, run_ = rem_ >> 3, pc_ = rem_ & 7, col_ = (run_ < 3 ? run_ * 512 + h * 64 : (run_ == 3 ? 1536 : 1600)) + pc_ * 8
#define RW_LOAD(t0) do { _Pragma("unroll") for (int it = 0; it < 5; ++it) { PIECE(it); const int t = (t0) + tok_; cur[it] = *(const GAS v4u*)(RWb + (size_t)t * RW_LD + col_); \
        prv[it] = (v4u){0u, 0u, 0u, 0u}; if (t > 0) prv[it] = *(const GAS v4u*)(RWb + (size_t)(t - 1) * RW_LD + col_); } } while (0)
    RW_LOAD(0);
    const int nt = w & 3, ich = 16 * nt + c, hc_e = h * 64 + ich;
    const float p_w0s = -LOG2E * F.w0[hc_e], p_a0s = -LOG2E * F.a0[hc_e], p_kk = F.k_k[hc_e], p_ka = F.k_a[hc_e], p_ka1 = 1.0f - p_ka;
    const int otok = tid >> 3, opart = tid & 7, hc_o = h * 64 + 8 * opart;
    f32x4 ST[4];
#pragma unroll
    for (int n = 0; n < 4; ++n) ST[n] = (f32x4){0.f, 0.f, 0.f, 0.f};
    __syncthreads();
#define SCAN_OUT(tbase) do { \
        const f32x4 y0 = *(const LAS f32x4*)(Y + otok * 64 + 8 * opart), y1 = *(const LAS f32x4*)(Y + otok * 64 + 8 * opart + 4); \
        const v4u vb = *(const LAS v4u*)(lds + VV_OFF + otok * RSTR + opart * 16), rb = *(const LAS v4u*)(lds + RT_OFF + otok * RSTR + opart * 16), kb = *(const LAS v4u*)(lds + KT_OFF + otok * RSTR + opart * 16); \
        const f32x4 rk0 = *(const LAS f32x4*)(CST + 512 + 8 * opart), rk1 = *(const LAS f32x4*)(CST + 516 + 8 * opart); \
        const f32x4 lw0 = *(const LAS f32x4*)(CST + 384 + 8 * opart), lw1 = *(const LAS f32x4*)(CST + 388 + 8 * opart), lb0 = *(const LAS f32x4*)(CST + 448 + 8 * opart), lb1 = *(const LAS f32x4*)(CST + 452 + 8 * opart); \
        const f32x4 v0 = (f32x4){bflo(vb.x), bfhi(vb.x), bflo(vb.y), bfhi(vb.y)}, v1 = (f32x4){bflo(vb.z), bfhi(vb.z), bflo(vb.w), bfhi(vb.w)}; \
        const f32x4 r0 = (f32x4){bflo(rb.x), bfhi(rb.x), bflo(rb.y), bfhi(rb.y)}, r1 = (f32x4){bflo(rb.z), bfhi(rb.z), bflo(rb.w), bfhi(rb.w)}; \
        const f32x4 k0 = (f32x4){bflo(kb.x), bfhi(kb.x), bflo(kb.y), bfhi(kb.y)}, k1 = (f32x4){bflo(kb.z), bfhi(kb.z), bflo(kb.w), bfhi(kb.w)}; \
        const f32x4 z0 = r0 * k0 * rk0, z1 = r1 * k1 * rk1; \
        const float bon = sum8(((z0[0] + z0[1]) + (z0[2] + z0[3])) + ((z1[0] + z1[1]) + (z1[2] + z1[3]))); \
        const float mu = sum8(((y0[0] + y0[1]) + (y0[2] + y0[3])) + ((y1[0] + y1[1]) + (y1[2] + y1[3]))) * (1.0f / 64.0f); const f32x4 d0 = y0 - mu, d1 = y1 - mu; \
        const float var = sum8(((d0[0] * d0[0] + d0[1] * d0[1]) + (d0[2] * d0[2] + d0[3] * d0[3])) + ((d1[0] * d1[0] + d1[1] * d1[1]) + (d1[2] * d1[2] + d1[3] * d1[3]))) * (1.0f / 64.0f); \
        const float rs = __builtin_amdgcn_rsqf(var + GN_EPS); \
        const f32x4 o0 = d0 * rs * lw0 + lb0 + v0 * bon, o1 = d1 * rs * lw1 + lb1 + v1 * bon; \
        v4u ow; ow.x = cvt2(o0[0], o0[1]); ow.y = cvt2(o0[2], o0[3]); ow.z = cvt2(o1[0], o1[1]); ow.w = cvt2(o1[2], o1[3]); \
        *(GAS v4u*)(F.OR + ((size_t)b * SEQ + (tbase) + otok) * 512 + hc_o) = ow; } while (0)

    for (int t0 = 0; t0 < SEQ; t0 += TC) {
        if (t0 > 0) SCAN_OUT(t0 - TC);
#pragma unroll
        for (int it = 0; it < 5; ++it) { PIECE(it);
            const f32x4 m0 = *(const LAS f32x4*)(CST + run_ * 64 + pc_ * 8), m1 = *(const LAS f32x4*)(CST + run_ * 64 + pc_ * 8 + 4);
            float x[8];
            { const v4u cu = cur[it], pr = prv[it];
              const float cv[8] = {bflo(cu.x), bfhi(cu.x), bflo(cu.y), bfhi(cu.y), bflo(cu.z), bfhi(cu.z), bflo(cu.w), bfhi(cu.w)};
              const float pv[8] = {bflo(pr.x), bfhi(pr.x), bflo(pr.y), bfhi(pr.y), bflo(pr.z), bfhi(pr.z), bflo(pr.w), bfhi(pr.w)};
              const float mv[8] = {m0[0], m0[1], m0[2], m0[3], m1[0], m1[1], m1[2], m1[3]};
#pragma unroll
              for (int e = 0; e < 8; ++e) x[e] = cv[e] + (pv[e] - cv[e]) * mv[e]; }
            if (run_ == 1) { const f32x4 k0 = *(const LAS f32x4*)(CST + 320 + pc_ * 8), k1 = *(const LAS f32x4*)(CST + 324 + pc_ * 8);
                float s = 0.f;
#pragma unroll
                for (int e = 0; e < 4; ++e) { const float z0 = x[e] * k0[e], z1 = x[4 + e] * k1[e]; s += z0 * z0 + z1 * z1; }
                __hip_atomic_fetch_add(SSQ + tok_, s, __ATOMIC_RELAXED, __HIP_MEMORY_SCOPE_WORKGROUP); }
            if (run_ == 3) {
#pragma unroll
                for (int e = 0; e < 8; ++e) { const float ex = __builtin_amdgcn_exp2f(2.0f * LOG2E * x[e]); x[e] = 1.0f - 2.0f * __builtin_amdgcn_rcpf(ex + 1.0f); } }
            v4u o; o.x = cvt2(x[0], x[1]); o.y = cvt2(x[2], x[3]); o.z = cvt2(x[4], x[5]); o.w = cvt2(x[6], x[7]);
            *(LAS v4u*)(lds + (run_ < 3 ? RB_OFF + run_ * 9216 : (run_ == 3 ? TW_OFF : AL_OFF)) + tok_ * RSTR + pc_ * 16) = o;
        }
        __syncthreads();
        if (t0 + TC < SEQ) RW_LOAD(t0 + TC);
#pragma unroll
        for (int half = 0; half < 2; ++half) { const int mt = 2 * (w >> 2) + half;
            f32x4 cw = (f32x4){0.f, 0.f, 0.f, 0.f}, ca = (f32x4){0.f, 0.f, 0.f, 0.f};
#pragma unroll
            for (int ks = 0; ks < 2; ++ks) {
                const bf16x8 atw = *(const LAS bf16x8*)(lds + TW_OFF + (16 * mt + c) * RSTR + (32 * ks + 8 * q) * 2), aal = *(const LAS bf16x8*)(lds + AL_OFF + (16 * mt + c) * RSTR + (32 * ks + 8 * q) * 2);
                const bf16x8 bw = *(const LAS bf16x8*)(lds + WUPT_OFF + (16 * nt + c) * RSTR + (32 * ks + 8 * q) * 2), ba = *(const LAS bf16x8*)(lds + AUPT_OFF + (16 * nt + c) * RSTR + (32 * ks + 8 * q) * 2);
                cw = MFMA32(atw, bw, cw); ca = MFMA32(aal, ba, ca); }
            float dc[4], av[4], bv[4], kv[4], rv[4]; unsigned short vraw[4];
#pragma unroll
            for (int reg = 0; reg < 4; ++reg) { const int tok = 16 * mt + 4 * q + reg, off = tok * RSTR + ich * 2;
                const float sg = __builtin_amdgcn_rcpf(1.0f + __builtin_amdgcn_exp2f(__builtin_fmaf(cw[reg], -LOG2E, p_w0s)));
                dc[reg] = __builtin_amdgcn_exp2f(-0.6065306597126334f * LOG2E * sg);
                const float al = __builtin_amdgcn_rcpf(1.0f + __builtin_amdgcn_exp2f(__builtin_fmaf(ca[reg], -LOG2E, p_a0s)));
                const float rr = bflo((unsigned)*(const LAS unsigned short*)(lds + RB_OFF + off)), kr = bflo((unsigned)*(const LAS unsigned short*)(lds + RB_OFF + 9216 + off));
                vraw[reg] = *(const LAS unsigned short*)(lds + RB_OFF + 18432 + off);
                const float kkn = kr * p_kk * __builtin_amdgcn_rsqf(fmaxf(SSQ[tok], 1e-24f));
                av[reg] = -kkn; bv[reg] = kkn * al; kv[reg] = kr * __builtin_fmaf(al, p_ka, p_ka1); rv[reg] = rr; }
            float P[4]; P[0] = dc[0]; P[1] = P[0] * dc[1]; P[2] = P[1] * dc[2]; P[3] = P[2] * dc[3];
            float pq = P[3]; { const float t1 = __shfl_up(pq, 16); if (q >= 1) pq *= t1; const float t2 = __shfl_up(pq, 32); if (q >= 2) pq *= t2; }
            float excl = __shfl_up(pq, 16); if (q == 0) excl = 1.0f;
#pragma unroll
            for (int reg = 0; reg < 4; ++reg) { const int tok = 16 * mt + 4 * q + reg, off = tok * RSTR + ich * 2;
                const float gP = excl * P[reg], gM = reg ? excl * P[reg - 1] : excl, gN = __builtin_amdgcn_rcpf(gP);
                *(LAS unsigned short*)(lds + AT_OFF + off) = (unsigned short)cvt2(av[reg] * gM, 0.f);
                *(LAS unsigned short*)(lds + RT_OFF + off) = (unsigned short)cvt2(rv[reg] * gP, 0.f);
                *(LAS unsigned short*)(lds + BT_OFF + off) = (unsigned short)cvt2(bv[reg] * gN, 0.f);
                *(LAS unsigned short*)(lds + KT_OFF + off) = (unsigned short)cvt2(kv[reg] * gN, 0.f);
                *(LAS unsigned short*)(lds + VV_OFF + off) = vraw[reg];
                if (q == 3 && reg == 3) GAM[mt * 64 + ich] = gP; }
        }
        __syncthreads();
        { const int ch = w & 3, tk0 = 16 * ch;
          const bf16x8 aA0 = *(const LAS bf16x8*)(lds + AT_OFF + (tk0 + c) * RSTR + (8 * q) * 2), aA1 = *(const LAS bf16x8*)(lds + AT_OFF + (tk0 + c) * RSTR + (32 + 8 * q) * 2);
          const f32x4 zero4 = (f32x4){0.f, 0.f, 0.f, 0.f};
          if (w < 4) {
              const bf16x8 bB0 = *(const LAS bf16x8*)(lds + BT_OFF + (tk0 + c) * RSTR + (8 * q) * 2), bB1 = *(const LAS bf16x8*)(lds + BT_OFF + (tk0 + c) * RSTR + (32 + 8 * q) * 2);
              f32x4 X = MFMA32(aA0, bB0, zero4); X = MFMA32(aA1, bB1, X);
              LAS unsigned char* xs = lds + XS_OFF + w * 512;
#pragma unroll
              for (int reg = 0; reg < 4; ++reg) *(LAS unsigned short*)(xs + (4 * q + reg) * 32 + c * 2) = (unsigned short)f2bf((c < 4 * q + reg) ? X[reg] : 0.f);
              const s16x4 aX = *(const LAS s16x4*)(xs + c * 32 + 8 * q);
              f32x4 I4;
#pragma unroll
              for (int reg = 0; reg < 4; ++reg) I4[reg] = (4 * q + reg == c) ? 1.f : 0.f;
              f32x4 Tt = I4;
#pragma unroll
              for (int it = 0; it < 15; ++it) Tt = MFMA16(aX, pack4(Tt), I4);
#pragma unroll
              for (int reg = 0; reg < 4; ++reg) *(LAS unsigned short*)(lds + TT_OFF + ch * 512 + (4 * q + reg) * 32 + c * 2) = (unsigned short)f2bf(Tt[reg]);
          } else {
              const bf16x8 aR0 = *(const LAS bf16x8*)(lds + RT_OFF + (tk0 + c) * RSTR + (8 * q) * 2), aR1 = *(const LAS bf16x8*)(lds + RT_OFF + (tk0 + c) * RSTR + (32 + 8 * q) * 2);
              const bf16x8 bB0 = *(const LAS bf16x8*)(lds + BT_OFF + (tk0 + c) * RSTR + (8 * q) * 2), bB1 = *(const LAS bf16x8*)(lds + BT_OFF + (tk0 + c) * RSTR + (32 + 8 * q) * 2);
              const bf16x8 bK0 = *(const LAS bf16x8*)(lds + KT_OFF + (tk0 + c) * RSTR + (8 * q) * 2), bK1 = *(const LAS bf16x8*)(lds + KT_OFF + (tk0 + c) * RSTR + (32 + 8 * q) * 2);
              f32x4 mk = MFMA32(aA0, bK0, zero4); mk = MFMA32(aA1, bK1, mk);
              f32x4 pb = MFMA32(aR0, bB0, zero4); pb = MFMA32(aR1, bB1, pb);
              f32x4 pk = MFMA32(aR0, bK0, zero4); pk = MFMA32(aR1, bK1, pk);
#pragma unroll
              for (int reg = 0; reg < 4; ++reg) { const int o = ch * 512 + (4 * q + reg) * 32 + c * 2; const bool lt = c < 4 * q + reg, le = c <= 4 * q + reg;
                  *(LAS unsigned short*)(lds + MK_OFF + o) = (unsigned short)f2bf(lt ? mk[reg] : 0.f);
                  *(LAS unsigned short*)(lds + PB_OFF + o) = (unsigned short)f2bf(le ? pb[reg] : 0.f);
                  *(LAS unsigned short*)(lds + PK_OFF + o) = (unsigned short)f2bf(le ? pk[reg] : 0.f); }
              if (w == 7) SSQ[lane] = 0.f;
          } }
        __syncthreads();
        if (w < 4) {
#pragma unroll
            for (int ch = 0; ch < 4; ++ch) { const int tk0 = 16 * ch;
                const int trow = (tk0 + 4 * q + (c >> 2)) * RSTR + (c & 3) * 8;
                s16x4 sb[4];
#pragma unroll
                for (int n = 0; n < 4; ++n) sb[n] = pack4(ST[n]);
                const s16x4 bV = vtr(lds + VV_OFF + trow + 32 * w);
                f32x4 WT = (f32x4){0.f, 0.f, 0.f, 0.f}, YT = (f32x4){0.f, 0.f, 0.f, 0.f};
#pragma unroll
                for (int n = 0; n < 4; ++n) { const s16x4 aA = *(const LAS s16x4*)(lds + AT_OFF + (tk0 + c) * RSTR + (16 * n + 4 * q) * 2), aR = *(const LAS s16x4*)(lds + RT_OFF + (tk0 + c) * RSTR + (16 * n + 4 * q) * 2);
                    WT = MFMA16(aA, sb[n], WT); YT = MFMA16(aR, sb[n], YT); }
                { const s16x4 aM = *(const LAS s16x4*)(lds + MK_OFF + ch * 512 + c * 32 + 8 * q), aPk = *(const LAS s16x4*)(lds + PK_OFF + ch * 512 + c * 32 + 8 * q);
                  WT = MFMA16(aM, bV, WT); YT = MFMA16(aPk, bV, YT); }
                const s16x4 aT = *(const LAS s16x4*)(lds + TT_OFF + ch * 512 + c * 32 + 8 * q);
                const f32x4 UT = MFMA16(aT, pack4(WT), ((f32x4){0.f, 0.f, 0.f, 0.f}));
                const s16x4 ub = pack4(UT);
                { const s16x4 aPb = *(const LAS s16x4*)(lds + PB_OFF + ch * 512 + c * 32 + 8 * q); YT = MFMA16(aPb, ub, YT); }
#pragma unroll
                for (int reg = 0; reg < 4; ++reg) Y[(tk0 + 4 * q + reg) * 64 + 16 * w + c] = YT[reg];
#pragma unroll
                for (int n = 0; n < 4; ++n) { const s16x4 aB = vtr(lds + BT_OFF + trow + 32 * n), aK = vtr(lds + KT_OFF + trow + 32 * n);
                    ST[n] = MFMA16(aB, ub, ST[n]); ST[n] = MFMA16(aK, bV, ST[n]);
                    const f32x4 gm = *(const LAS f32x4*)(GAM + ch * 64 + 16 * n + 4 * q); ST[n] = ST[n] * gm; }
            }
        }
        __syncthreads();
    }
    SCAN_OUT(SEQ - TC);
#undef RW_LOAD
#undef PIECE
#undef SCAN_OUT
    __syncthreads();
}
}

__device__ __forceinline__ void p456_chain(Frame& F) {
        const pg8::PanelOrder S{F.vcu, 4};
        { pg8::Gemm g{F.A1, F.WTA, 2 * M, 2 * D, 512}; const pg8::PanelOrder2 S2{F.vcu}; pg8::EpiMerge2 E{F.SGA, F.SGB, F.MG};
          pg8::gemm_phase<pg8::EpiMerge2, pg8::PanelOrder2, true, true>(F.lds, g, S2, E); }
        VM_WAIT(); __syncthreads();
        if (threadIdx.x == 0) { __builtin_amdgcn_fence(__ATOMIC_ACQUIRE, "agent"); VM_WAIT(); }
        LAS float* ss = (LAS float*)(F.lds + SS_OFF);
        if (threadIdx.x < 256) ss[threadIdx.x] = 0.f;
        __syncthreads();
        { pg8::Gemm g{F.MG, F.WTO, M, D, D}; pg8::EpiOut E{F.out, ss};
          pg8::gemm_phase<pg8::EpiOut, pg8::PanelOrder, true, true>(F.lds, g, S, E); }
        VM_WAIT(); LDS_WAIT(); __syncthreads();
        if (threadIdx.x == 0) { __builtin_amdgcn_fence(__ATOMIC_ACQUIRE, "agent"); VM_WAIT(); }
        __syncthreads();
        int t2 = threadIdx.x; asm volatile("" : "+v"(t2)); const int lane2 = t2 & 63, wave2 = __builtin_amdgcn_readfirstlane(t2 >> 6);
        for (int r = wave2; r < 256; r += NWAVES) { const size_t row = (size_t)F.vcu * 256 + r; const float rstd = 1.0f / sqrtf(ss[r] * (1.0f / D) + RMS_EPS);
            float* orow = F.out + row * D; const float* xrow = F.x + row * D;
            v4u raw[2];
#pragma unroll
            for (int j = 0; j < 2; ++j) raw[j] = *((const GAS v4u*)orow + lane2 + 64 * j);
#pragma unroll
            for (int j = 0; j < 2; ++j) { const int col = 8 * lane2 + 512 * j;
                const f32x4 x0 = *(const GAS f32x4*)(xrow + col), x1 = *(const GAS f32x4*)(xrow + col + 4), g0 = *(const GAS f32x4*)(F.post_g + col), g1 = *(const GAS f32x4*)(F.post_g + col + 4);
                const f32x4 r0 = (f32x4){bflo(raw[j].x), bfhi(raw[j].x), bflo(raw[j].y), bfhi(raw[j].y)}, r1 = (f32x4){bflo(raw[j].z), bfhi(raw[j].z), bflo(raw[j].w), bfhi(raw[j].w)};
                *(GAS f32x4*)(orow + col) = x0 + r0 * rstd * g0; *(GAS f32x4*)(orow + col + 4) = x1 + r1 * rstd * g1; } }
    }

#ifndef MK_N_LAUNCHES
#define MK_N_LAUNCHES 1
#endif
constexpr int N_LAUNCHES = MK_N_LAUNCHES;
#ifndef REP_P0
#define REP_P0 1
#endif
#ifndef REP_P1
#define REP_P1 1
#endif
#ifndef REP_SCAN
#define REP_SCAN 1
#endif
#ifndef REP_P3
#define REP_P3 1
#endif
#ifndef REP_P4
#define REP_P4 1
#endif
#ifndef TSPROBE
#define TSPROBE -1
#endif
#if TSPROBE >= 0
#define TS_MARK(k) do { if (blockIdx.x == 0 && threadIdx.x == 0) __hip_atomic_store((unsigned long long*)(args.ws + 512 * 1024) + (k), (unsigned long long)__builtin_amdgcn_s_memrealtime(), __ATOMIC_RELAXED, __HIP_MEMORY_SCOPE_AGENT); } while (0)
#else
#define TS_MARK(k) do { } while (0)
#endif
constexpr int N_PHASES = 5;
struct Args { const float* in[18]; float* out; unsigned char* ws; int ph_lo, ph_hi; };
__global__ void __launch_bounds__(NWAVES * 64, 2) mk_fwd(Args args) {
    extern __shared__ __attribute__((aligned(16))) unsigned char lds[];
    Frame F;
    F.lds = (LAS unsigned char*)lds;
    F.MISC = (volatile LAS unsigned*)(F.lds + MISC_OFF);
    F.tid = threadIdx.x; F.lane = F.tid & 63; F.wave = __builtin_amdgcn_readfirstlane(F.tid >> 6);
    F.G = gridDim.x; { const int bx = blockIdx.x; F.vcu = (F.G % 8 == 0) ? (bx % 8) * (F.G / 8) + bx / 8 : bx; }
    unsigned char* ws = args.ws;
    F.ctl = (gu32*)(ws + WS_CTL);
    F.x = args.in[0]; F.pre_g = args.in[1]; F.w_in = args.in[2]; F.rel_bias = args.in[3]; F.mix = args.in[4]; F.w0 = args.in[5]; F.w_up = args.in[6]; F.a0 = args.in[7]; F.a_up = args.in[8];
    F.k_k = args.in[9]; F.k_a = args.in[10]; F.r_k = args.in[11]; F.ln_w = args.in[12]; F.ln_b = args.in[13]; F.w_upA = args.in[14]; F.w_upB = args.in[15]; F.w_out = args.in[16]; F.post_g = args.in[17];
    F.out = args.out;
    F.WT1 = (bf16*)(ws + WS_WT1); F.WTA = (bf16*)(ws + WS_WTA); F.WTB = (bf16*)(ws + WS_WTB); F.WTO = (bf16*)(ws + WS_WTO); F.LSE = (float*)(ws + WS_LSE);
    F.H = (bf16*)(ws + WS_H); F.QKV = (bf16*)(ws + WS_QKV); F.RW = (bf16*)(ws + WS_RW);
    F.SGA = (bf16*)(ws + WS_SGA); F.SGB = (bf16*)(ws + WS_SGB); F.A1 = (bf16*)(ws + WS_A1); F.A2 = (bf16*)(ws + WS_A2); F.MG = (bf16*)(ws + WS_MG);
    F.OA = (bf16*)((unsigned char*)args.out + OUT_OA); F.OR = (bf16*)((unsigned char*)args.out + OUT_OR);
    for (int u = F.tid; u < (LDS_BYTES - LDSCTL_OFF) / 4; u += NWAVES * 64) ((LAS unsigned*)(F.lds + LDSCTL_OFF))[u] = 0u;
    __syncthreads();
    XcdBarrier bar; bar.bar = (unsigned*)(F.ctl + CW_BAR); bar.x = 0; bar.st = nullptr;
    if (N_LAUNCHES == 1) bar = xcd_barrier_post((unsigned*)(F.ctl + CW_BAR), F.MISC + 8);
    const int lo = args.ph_lo, hi = args.ph_hi;
#define IN(k) (lo <= (k) && (k) < hi)
#define BOTH(k) (IN(k) && IN((k) + 1))
#define GRID_BAR() do { if (N_LAUNCHES == 1) xcd_barrier(bar); } while (0)

    TS_MARK(0);
    if (IN(0)) { for (int rep = 0; rep < REP_P0; ++rep) p0_prologue(F); if (BOTH(0)) GRID_BAR(); }

    TS_MARK(1);
    if (IN(1)) {
        pg8::Gemm g{F.H, F.WT1, M, N1, D}; pg8::StaticOrder S; S.init(M, N1, F.G, (int)blockIdx.x);
        pg8::Epi1 E{F.QKV, F.RW};
        pg8::gemm_phase<pg8::Epi1, pg8::StaticOrder, true, true>(F.lds, g, S, E);
#if REP_P1 == 2
        pg8::gemm_phase<pg8::Epi1, pg8::StaticOrder, true, true>(F.lds, g, S, E);
#endif
        if (BOTH(1)) GRID_BAR();
    }

    TS_MARK(2);
    if (IN(2)) {
        att::attn_phase(F);
        TS_MARK(3);
        rwkv::scan_phase(F);
#if REP_SCAN == 2
        rwkv::scan_phase(F);
#endif
        if (BOTH(2)) GRID_BAR();
    }

    TS_MARK(4);
    if (IN(3)) {
        pg8::Gemm g{F.H, F.WT1 + (size_t)N1 * D, M, N2, D}; pg8::StaticOrder S; S.init(M, N2, F.G, (int)blockIdx.x);
        pg8::Epi2 E{F.OA, F.OR, F.A1, F.A2, F.SGA, F.SGB};
        pg8::gemm_phase<pg8::Epi2, pg8::StaticOrder, true, true>(F.lds, g, S, E);
#if REP_P3 == 2
        pg8::gemm_phase<pg8::Epi2, pg8::StaticOrder, true, true>(F.lds, g, S, E);
#endif
        if (BOTH(3)) GRID_BAR();
    }

    TS_MARK(5);
    if (IN(4) && F.vcu < M / 256) {
        p456_chain(F);
#if REP_P4 == 2
        p456_chain(F);
#endif
    }
#if TSPROBE >= 0
    if (blockIdx.x == 0 && threadIdx.x == 0) { VM_WAIT(); const unsigned long long t6 = __builtin_amdgcn_s_memrealtime(); unsigned long long* tsb = (unsigned long long*)(args.ws + 512 * 1024);
        const unsigned long long ta = __hip_atomic_load(tsb + TSPROBE, __ATOMIC_RELAXED, __HIP_MEMORY_SCOPE_AGENT), t0 = __hip_atomic_load(tsb, __ATOMIC_RELAXED, __HIP_MEMORY_SCOPE_AGENT);
        const unsigned long long tb = (TSPROBE == 5) ? t6 : __hip_atomic_load(tsb + TSPROBE + 1, __ATOMIC_RELAXED, __HIP_MEMORY_SCOPE_AGENT);
        const float frac = (float)(tb - ta) / (float)(t6 - t0); F.out[0] += 0.25f + 0.5f * frac; }
#endif
#undef IN
#undef BOTH
#undef GRID_BAR
}

extern "C" void kernel_launch(void* const* d_in, const int* in_sizes, int n_in, void* d_out, int out_size, void* d_ws, size_t ws_size, hipStream_t stream) {
    static int grid = 0;
    if (grid == 0) {
        if (n_in != 18 || in_sizes[0] != M * D || out_size != M * D || ws_size < WS_END) { fprintf(stderr, "kernel_launch: unexpected shapes / workspace: n_in %d in0 %d out %d ws %zu (need %zu)\n", n_in, n_in > 0 ? in_sizes[0] : -1, out_size, ws_size, (size_t)WS_END); grid = -1; return; }
        int dev = 0, cus = 0, per_cu = 0;
        if (hipGetDevice(&dev) != hipSuccess || hipDeviceGetAttribute(&cus, hipDeviceAttributeMultiprocessorCount, dev) != hipSuccess) { grid = -1; return; }
        if (hipFuncSetAttribute((const void*)mk_fwd, hipFuncAttributeMaxDynamicSharedMemorySize, LDS_BYTES) != hipSuccess) { fprintf(stderr, "kernel_launch: hipFuncSetAttribute failed\n"); grid = -1; return; }
        if (hipOccupancyMaxActiveBlocksPerMultiprocessor(&per_cu, (const void*)mk_fwd, NWAVES * 64, LDS_BYTES) != hipSuccess || per_cu < 1) fprintf(stderr, "kernel_launch: occupancy query reports %d\n", per_cu);
        (void)hipGetLastError();
        grid = cus;
        if (grid != 256) fprintf(stderr, "kernel_launch: %d CUs (built for 256)\n", grid);
        fprintf(stderr, "kernel_launch: ws_size %zu, grid %d, per_cu %d\n", ws_size, grid, per_cu);
    }
    if (grid < 0) return;
    if (hipMemsetAsync((char*)d_ws + WS_CTL, 0, CTL_ZERO_BYTES, stream) != hipSuccess) return;
    Args a{};
    for (int i = 0; i < 18; ++i) a.in[i] = (const float*)d_in[i];
    a.out = (float*)d_out; a.ws = (unsigned char*)d_ws;
    for (int li = 0; li < N_LAUNCHES; ++li) {
        a.ph_lo = (N_LAUNCHES == 1) ? 0 : li; a.ph_hi = (N_LAUNCHES == 1) ? N_PHASES : li + 1;
        hipLaunchKernelGGL(mk_fwd, dim3(grid), dim3(NWAVES * 64), LDS_BYTES, stream, a);
        if (hipPeekAtLastError() != hipSuccess) { fprintf(stderr, "kernel_launch: launch %d failed\n", li); break; }
    }
}
```

```cpp
#include <hip/hip_runtime.h>
#include <cstdio>
#include <cstdint>
namespace pg8 {
#define PG8_LAS __attribute__((address_space(3)))
typedef unsigned short bf16_t;
typedef short bf16x8 __attribute__((ext_vector_type(8)));
typedef float f32x4 __attribute__((ext_vector_type(4)));
typedef unsigned u32x4 __attribute__((ext_vector_type(4)));
constexpr int BM = 256, BK = 64, HALF = 128, HTB = HALF * BK * 2  , STAGE_BYTES = 8 * HTB, NXCD = 8, WGM = 8;

__host__ __device__ __forceinline__ int lds_byte(int r, int c) { const int st = (r >> 4) * 2 + (c >> 5), rr = r & 15, cc = c & 31, ob = rr * 64 + cc * 2; return st * 1024 + (ob ^ (((ob >> 9) & 1) << 5)); }
__host__ __device__ __forceinline__ void stage_rc(int b, int& R, int& C) { const int st = b / 1024, sb = b % 1024, swz = sb ^ (((sb >> 9) & 1) << 5); R = (st >> 1) * 16 + swz / 64; C = (st & 1) * 32 + (swz % 64) / 2; }
__host__ __device__ __forceinline__ int perm32(int rho) { const int n = rho >> 4, i = rho & 15; return 8 * (i >> 2) + 4 * n + (i & 3); }

struct Unit { int pm, pn; };
struct Gemm { const bf16_t* A; const bf16_t* Bt; int M, N, K; };

struct StaticOrder {
    int nM, nN, nwg, G, c;
    __host__ __device__ void init(int M, int N, int G_, int c_) { nM = M / BM; nN = N / BM; nwg = nM * nN; G = G_; c = c_; }
    __host__ __device__ bool next(int i, Unit& u) const {
        const long L = (long)i * G + c; if (L >= nwg) return false;
        int wgid = (int)L; { const int q = nwg / NXCD, r = nwg % NXCD, xcd = wgid % NXCD, off = wgid / NXCD; wgid = (xcd < r ? xcd * (q + 1) : r * (q + 1) + (xcd - r) * q) + off; }
        const int nig = WGM * nN, gid = wgid / nig, fm = gid * WGM, gsz = (nM - fm) < WGM ? (nM - fm) : WGM;
        u.pm = fm + ((wgid % nig) % gsz); u.pn = (wgid % nig) / gsz; return true;
    }
    __device__ __forceinline__ void a_ready(const Unit&) const {}
    __device__ __forceinline__ void done(const Unit&) const {}
};

__device__ __forceinline__ unsigned cvt_pk_bf16(float lo, float hi) { unsigned r; asm volatile("v_cvt_pk_bf16_f32 %0, %1, %2" : "=v"(r) : "v"(lo), "v"(hi)); return r; }
typedef unsigned u32x4 __attribute__((ext_vector_type(4)));
typedef unsigned u32x2 __attribute__((ext_vector_type(2)));
__device__ __forceinline__ float bf_lo(unsigned w) { return __builtin_bit_cast(float, w << 16); }
__device__ __forceinline__ float bf_hi(unsigned w) { return __builtin_bit_cast(float, w & 0xffff0000u); }
__device__ __forceinline__ float sigmoid_f(float z) { return __builtin_amdgcn_rcpf(1.0f + __builtin_amdgcn_exp2f(-1.4426950408889634f * z)); }
constexpr float QSCALE = 0.125f * 1.4426950408889634f;

struct PanelOrder {
    int pm, nN;
    __device__ __forceinline__ bool next(int i, Unit& u) const { if (i >= nN) return false; u.pm = pm; u.pn = i; return true; }
    __device__ __forceinline__ void a_ready(const Unit&) const {}
    __device__ __forceinline__ void done(const Unit&) const {}
};

struct Epi1 {
    static constexpr bool PERM = true, AFTER_DRAIN = false;
    bf16_t* QKV; bf16_t* RW;
    __device__ __forceinline__ void operator()(const f32x4 (&acc)[2][2][4][2], const Unit& u, int wr, int wc, int fr, int fq) const {
        const int row0 = u.pm * BM + wr * 64 + fr;
        bf16_t* base; int ldc, colt; float sc = 1.f;
        if (u.pn < 18) { base = QKV; ldc = 4608; colt = u.pn * BM; if (u.pn < 6) sc = QSCALE; } else { base = RW; ldc = 1792; colt = (u.pn - 18) * BM; }
        const int col0 = colt + wc * 32 + 8 * fq;
#pragma unroll
        for (int ai = 0; ai < 2; ++ai)
#pragma unroll
            for (int m = 0; m < 4; ++m) { bf16_t* rowp = base + (size_t)(row0 + ai * HALF + m * 16) * ldc + col0;
#pragma unroll
                for (int bj = 0; bj < 2; ++bj) { const f32x4 v0 = acc[ai][bj][m][0] * sc, v1 = acc[ai][bj][m][1] * sc;
                    u32x4 w; w.x = cvt_pk_bf16(v0[0], v0[1]); w.y = cvt_pk_bf16(v0[2], v0[3]); w.z = cvt_pk_bf16(v1[0], v1[1]); w.w = cvt_pk_bf16(v1[2], v1[3]);
                    *(u32x4*)(rowp + bj * HALF) = w; } }
    }
};

struct Epi2 {
    static constexpr bool PERM = true, AFTER_DRAIN = false;
    const bf16_t* OA; const bf16_t* OR; bf16_t* A1; bf16_t* A2; bf16_t* SGA; bf16_t* SGB;
    __device__ __forceinline__ void operator()(const f32x4 (&acc)[2][2][4][2], const Unit& u, int wr, int wc, int fr, int fq) const {
        const int row0 = u.pm * BM + wr * 64 + fr;
        const bf16_t* mul; bf16_t* dst; int ldc, colt;
        if (u.pn < 2) { mul = OA; dst = A1; ldc = 512; colt = u.pn * BM; }
        else if (u.pn < 4) { mul = OR; dst = A2; ldc = 512; colt = (u.pn - 2) * BM; }
        else if (u.pn < 8) { mul = nullptr; dst = SGA; ldc = 1024; colt = (u.pn - 4) * BM; }
        else { mul = nullptr; dst = SGB; ldc = 1024; colt = (u.pn - 8) * BM; }
        const int col0 = colt + wc * 32 + 8 * fq;
#pragma unroll
        for (int ai = 0; ai < 2; ++ai)
#pragma unroll
            for (int m = 0; m < 4; ++m) { const size_t off = (size_t)(row0 + ai * HALF + m * 16) * ldc + col0;
#pragma unroll
                for (int bj = 0; bj < 2; ++bj) { const f32x4 z0 = acc[ai][bj][m][0], z1 = acc[ai][bj][m][1];
                    float f[8];
#pragma unroll
                    for (int e = 0; e < 4; ++e) { f[e] = sigmoid_f(z0[e]); f[4 + e] = sigmoid_f(z1[e]); }
                    if (mul) { const u32x4 o = *(const u32x4*)(mul + off + bj * HALF);
#pragma unroll
                        for (int e = 0; e < 4; ++e) { f[e] *= z0[e]; f[4 + e] *= z1[e]; }
                        f[0] *= bf_lo(o.x); f[1] *= bf_hi(o.x); f[2] *= bf_lo(o.y); f[3] *= bf_hi(o.y); f[4] *= bf_lo(o.z); f[5] *= bf_hi(o.z); f[6] *= bf_lo(o.w); f[7] *= bf_hi(o.w); }
                    u32x4 w; w.x = cvt_pk_bf16(f[0], f[1]); w.y = cvt_pk_bf16(f[2], f[3]); w.z = cvt_pk_bf16(f[4], f[5]); w.w = cvt_pk_bf16(f[6], f[7]);
                    *(u32x4*)(dst + off + bj * HALF) = w; } }
    }
};

struct PanelOrder2 {
    int pm;
    __device__ __forceinline__ bool next(int i, Unit& u) const { if (i >= 8) return false; u.pm = pm + (i >= 4 ? 256 : 0); u.pn = i; return true; }
    __device__ __forceinline__ void a_ready(const Unit&) const {}
    __device__ __forceinline__ void done(const Unit&) const {}
};
struct EpiMerge2 {
    static constexpr bool PERM = true, AFTER_DRAIN = false;
    const bf16_t* SGA; const bf16_t* SGB; bf16_t* MG;
    __device__ __forceinline__ void operator()(const f32x4 (&acc)[2][2][4][2], const Unit& u, int wr, int wc, int fr, int fq) const {
        const bool add = u.pn >= 4; const bf16_t* SG = add ? SGB : SGA;
        const int row0 = (u.pm & 255) * BM + wr * 64 + fr, col0 = (u.pn & 3) * BM + wc * 32 + 8 * fq;
#pragma unroll
        for (int ai = 0; ai < 2; ++ai)
#pragma unroll
            for (int m = 0; m < 4; ++m) { const size_t off = (size_t)(row0 + ai * HALF + m * 16) * 1024 + col0;
#pragma unroll
                for (int bj = 0; bj < 2; ++bj) { const f32x4 z0 = acc[ai][bj][m][0], z1 = acc[ai][bj][m][1];
                    const u32x4 g = *(const u32x4*)(SG + off + bj * HALF);
                    float f[8];
                    f[0] = z0[0] * bf_lo(g.x); f[1] = z0[1] * bf_hi(g.x); f[2] = z0[2] * bf_lo(g.y); f[3] = z0[3] * bf_hi(g.y);
                    f[4] = z1[0] * bf_lo(g.z); f[5] = z1[1] * bf_hi(g.z); f[6] = z1[2] * bf_lo(g.w); f[7] = z1[3] * bf_hi(g.w);
                    if (add) { const u32x4 p = *(const u32x4*)(MG + off + bj * HALF);
                        f[0] += bf_lo(p.x); f[1] += bf_hi(p.x); f[2] += bf_lo(p.y); f[3] += bf_hi(p.y); f[4] += bf_lo(p.z); f[5] += bf_hi(p.z); f[6] += bf_lo(p.w); f[7] += bf_hi(p.w); }
                    u32x4 w; w.x = cvt_pk_bf16(f[0], f[1]); w.y = cvt_pk_bf16(f[2], f[3]); w.z = cvt_pk_bf16(f[4], f[5]); w.w = cvt_pk_bf16(f[6], f[7]);
                    *(u32x4*)(MG + off + bj * HALF) = w; } }
    }
};

struct EpiOut {
    static constexpr bool PERM = true, AFTER_DRAIN = false;
    float* OUT; PG8_LAS float* ss;
    __device__ __forceinline__ void operator()(const f32x4 (&acc)[2][2][4][2], const Unit& u, int wr, int wc, int fr, int fq) const {
        const int row0 = u.pm * BM + wr * 64 + fr, col0 = u.pn * BM + wc * 32 + 8 * fq;
#pragma unroll
        for (int ai = 0; ai < 2; ++ai)
#pragma unroll
            for (int m = 0; m < 4; ++m) { bf16_t* rowp = (bf16_t*)(OUT + (size_t)(row0 + ai * HALF + m * 16) * 1024) + col0; float q = 0.f;
#pragma unroll
                for (int bj = 0; bj < 2; ++bj) { const f32x4 z0 = acc[ai][bj][m][0], z1 = acc[ai][bj][m][1];
                    q += (z0[0] * z0[0] + z0[1] * z0[1]) + (z0[2] * z0[2] + z0[3] * z0[3]) + (z1[0] * z1[0] + z1[1] * z1[1]) + (z1[2] * z1[2] + z1[3] * z1[3]);
                    u32x4 w; w.x = cvt_pk_bf16(z0[0], z0[1]); w.y = cvt_pk_bf16(z0[2], z0[3]); w.z = cvt_pk_bf16(z1[0], z1[1]); w.w = cvt_pk_bf16(z1[2], z1[3]);
                    *(u32x4*)(rowp + bj * HALF) = w; }
                q += __shfl_xor(q, 16); q += __shfl_xor(q, 32);
                if (fq == 0) __hip_atomic_fetch_add(ss + (ai * HALF + wr * 64 + m * 16 + fr), q, __ATOMIC_RELAXED, __HIP_MEMORY_SCOPE_WORKGROUP); }
    }
};

template <class Epi, class Sched, bool ALIGN_EPI = false, bool SP2 = false>
__device__ __forceinline__ void gemm_phase(PG8_LAS unsigned char* lds, const Gemm g, const Sched& S, const Epi& E) {
    const int tid = threadIdx.x, wid = __builtin_amdgcn_readfirstlane(tid >> 6), lane = tid & 63, wr = wid >> 2, wc = wid & 3, fr = lane & 15, fq = lane >> 4;
    const int K = g.K, nt = K / BK;
    unsigned voffA[2], voffB[2];
#pragma unroll
    for (int i = 0; i < 2; ++i) { int R, C; stage_rc(tid * 16 + i * 8192, R, C); const int Rb = Epi::PERM ? ((R & ~31) + perm32(R & 31)) : R;
        voffA[i] = (unsigned)(R * K + C) * 2u; voffB[i] = (unsigned)(Rb * K + C) * 2u; }
    const size_t kstep = (size_t)(BK * 2);
    const size_t hstep = (size_t)HALF * K * 2;
    const size_t tstep = 2 * hstep;
    const unsigned ldsw = (unsigned)wid * 1024u;
    const int aoff = lds_byte(wr * 64 + fr, fq * 8), boff = lds_byte(wc * 32 + fr, fq * 8);
#define PG8_SA(b, h) (((b) * 2 + (h)) * HTB)
#define PG8_SB(b, h) ((4 + (b) * 2 + (h)) * HTB)
#define PG8_STAGE(bufoff, gbase, voff) do { _Pragma("unroll") for (int _i = 0; _i < 2; ++_i) \
        __builtin_amdgcn_global_load_lds((const unsigned*)((const char*)(gbase) + (voff)[_i]), (PG8_LAS unsigned*)(lds + (bufoff) + ldsw + _i * 8192), 16, 0, 0); } while (0)
#define PG8_LDA(dst, b, h) do { _Pragma("unroll") for (int m = 0; m < 4; ++m) _Pragma("unroll") for (int k = 0; k < 2; ++k) dst[m][k] = *(const PG8_LAS bf16x8*)(lds + PG8_SA(b, h) + aoff + m * 2048 + k * 1024); } while (0)
#define PG8_LDB(dst, b, h) do { _Pragma("unroll") for (int n = 0; n < 2; ++n) _Pragma("unroll") for (int k = 0; k < 2; ++k) dst[n][k] = *(const PG8_LAS bf16x8*)(lds + PG8_SB(b, h) + boff + n * 2048 + k * 1024); } while (0)
#define PG8_MMA(ai, bj, At, Bt) do { __builtin_amdgcn_s_setprio(1); _Pragma("unroll") for (int m = 0; m < 4; ++m) _Pragma("unroll") for (int n = 0; n < 2; ++n) _Pragma("unroll") for (int k = 0; k < 2; ++k) \
        acc[ai][bj][m][n] = __builtin_amdgcn_mfma_f32_16x16x32_bf16(Bt[n][k], At[m][k], acc[ai][bj][m][n], 0, 0, 0); __builtin_amdgcn_s_setprio(0); } while (0)
#define PG8_WAIT_V(n) asm volatile("s_waitcnt vmcnt(" #n ")" ::: "memory")
#define PG8_WAIT_L(n) asm volatile("s_waitcnt lgkmcnt(" #n ")" ::: "memory")
#define PG8_BAR __builtin_amdgcn_s_barrier()
#define PG8_SCHED __builtin_amdgcn_sched_barrier(0)
    Unit cur, nxt; int ui = 0;
    if (!S.next(0, cur)) return;
    f32x4 acc[2][2][4][2];
#pragma unroll
    for (int a = 0; a < 2; ++a)
#pragma unroll
        for (int b = 0; b < 2; ++b)
#pragma unroll
            for (int m = 0; m < 4; ++m)
#pragma unroll
                for (int n = 0; n < 2; ++n) acc[a][b][m][n] = (f32x4){0.f, 0.f, 0.f, 0.f};
    bf16x8 At[4][2], B0[2][2], B1[2][2];
    const char* cA = (const char*)g.A + (size_t)cur.pm * tstep; const char* cB = (const char*)g.Bt + (size_t)cur.pn * tstep;
    S.a_ready(cur);
    if constexpr (SP2) {
        PG8_STAGE(PG8_SB(0, 0), cB, voffB); PG8_STAGE(PG8_SB(0, 1), cB + hstep, voffB); PG8_STAGE(PG8_SA(0, 0), cA, voffA); PG8_STAGE(PG8_SA(0, 1), cA + hstep, voffA);
        if (wr == 1) PG8_BAR;
        PG8_WAIT_V(2); PG8_BAR;
        PG8_STAGE(PG8_SB(1, 0), cB + kstep, voffB); PG8_STAGE(PG8_SA(1, 0), cA + kstep, voffA); PG8_STAGE(PG8_SB(1, 1), cB + hstep + kstep, voffB);
        PG8_WAIT_V(6); PG8_BAR;
    } else {
        PG8_STAGE(PG8_SB(0, 0), cB, voffB); PG8_STAGE(PG8_SA(0, 0), cA, voffA); PG8_STAGE(PG8_SB(0, 1), cB + hstep, voffB); PG8_STAGE(PG8_SA(0, 1), cA + hstep, voffA);
        if (wr == 1) PG8_BAR;
        PG8_WAIT_V(4); PG8_BAR;
        PG8_STAGE(PG8_SB(1, 0), cB + kstep, voffB); PG8_STAGE(PG8_SA(1, 0), cA + kstep, voffA); PG8_STAGE(PG8_SB(1, 1), cB + hstep + kstep, voffB);
        PG8_WAIT_V(6); PG8_BAR;
    }
    for (;;) {
        const bool has_next = S.next(ui + 1, nxt);
        const char* nA = has_next ? (const char*)g.A + (size_t)nxt.pm * tstep : cA; const char* nB = has_next ? (const char*)g.Bt + (size_t)nxt.pn * tstep : cB;
        for (int t = 0; t < nt; t += 2) {
            const bool last = (t == nt - 2);
            const char* a1 = cA + (size_t)(t + 1) * kstep;
            const char* a2 = last ? nA : cA + (size_t)(t + 2) * kstep; const char* b2 = last ? nB : cB + (size_t)(t + 2) * kstep;
            const char* a3 = a2 + kstep; const char* b3 = b2 + kstep;
            if (last && has_next) S.a_ready(nxt);
            if constexpr (SP2) {
            PG8_LDB(B0, 0, 0); PG8_LDB(B1, 0, 1); PG8_SCHED; PG8_LDA(At, 0, 0); PG8_STAGE(PG8_SA(1, 1), a1 + hstep, voffA);
            PG8_WAIT_V(8); PG8_WAIT_L(0); PG8_BAR; PG8_MMA(0, 0, At, B0); PG8_MMA(0, 1, At, B1); PG8_BAR; PG8_SCHED;
            PG8_LDA(At, 0, 1); PG8_STAGE(PG8_SB(0, 0), b2, voffB); PG8_STAGE(PG8_SB(0, 1), b2 + hstep, voffB); PG8_STAGE(PG8_SA(0, 0), a2, voffA);
            PG8_WAIT_V(8); PG8_WAIT_L(0); PG8_BAR; PG8_MMA(1, 0, At, B0); PG8_MMA(1, 1, At, B1); PG8_BAR; PG8_SCHED;
            PG8_LDB(B0, 1, 0); PG8_LDB(B1, 1, 1); PG8_SCHED; PG8_LDA(At, 1, 0); PG8_STAGE(PG8_SA(0, 1), a2 + hstep, voffA);
            PG8_WAIT_V(8); PG8_WAIT_L(0); PG8_BAR; PG8_MMA(0, 0, At, B0); PG8_MMA(0, 1, At, B1); PG8_BAR; PG8_SCHED;
            PG8_LDA(At, 1, 1); PG8_STAGE(PG8_SB(1, 0), b3, voffB); PG8_STAGE(PG8_SB(1, 1), b3 + hstep, voffB); PG8_STAGE(PG8_SA(1, 0), a3, voffA);
            PG8_WAIT_V(8); PG8_WAIT_L(0); PG8_BAR; PG8_MMA(1, 0, At, B0); PG8_MMA(1, 1, At, B1); PG8_BAR; PG8_SCHED;
            } else {
            PG8_LDB(B0, 0, 0); PG8_SCHED; PG8_LDA(At, 0, 0); PG8_STAGE(PG8_SA(1, 1), a1 + hstep, voffA);
            PG8_WAIT_L(8); PG8_BAR; PG8_WAIT_L(0); PG8_MMA(0, 0, At, B0); PG8_BAR; PG8_SCHED;
            PG8_LDB(B1, 0, 1); PG8_STAGE(PG8_SB(0, 0), b2, voffB);
            PG8_BAR; PG8_WAIT_L(0); PG8_MMA(0, 1, At, B1); PG8_BAR;
            PG8_LDA(At, 0, 1); PG8_STAGE(PG8_SA(0, 0), a2, voffA);
            PG8_BAR; PG8_WAIT_L(0); PG8_MMA(1, 0, At, B0); PG8_BAR; PG8_SCHED;
            PG8_STAGE(PG8_SB(0, 1), b2 + hstep, voffB);
            PG8_WAIT_V(6); PG8_BAR; PG8_MMA(1, 1, At, B1); PG8_BAR;
            PG8_LDB(B0, 1, 0); PG8_SCHED; PG8_LDA(At, 1, 0); PG8_STAGE(PG8_SA(0, 1), a2 + hstep, voffA);
            PG8_WAIT_L(8); PG8_BAR; PG8_WAIT_L(0); PG8_MMA(0, 0, At, B0); PG8_BAR; PG8_SCHED;
            PG8_LDB(B1, 1, 1); PG8_STAGE(PG8_SB(1, 0), b3, voffB);
            PG8_BAR; PG8_WAIT_L(0); PG8_MMA(0, 1, At, B1); PG8_BAR;
            PG8_LDA(At, 1, 1); PG8_STAGE(PG8_SA(1, 0), a3, voffA);
            PG8_BAR; PG8_WAIT_L(0); PG8_MMA(1, 0, At, B0); PG8_BAR; PG8_SCHED;
            PG8_STAGE(PG8_SB(1, 1), b3 + hstep, voffB);
            PG8_WAIT_V(6); PG8_BAR; PG8_MMA(1, 1, At, B1); PG8_BAR;
            }
        }
        if constexpr (ALIGN_EPI) { if (wr == 0) PG8_BAR; }
        if constexpr (!Epi::AFTER_DRAIN) { E(acc, cur, wr, wc, fr, fq); S.done(cur); }
        if (!has_next) break;
#pragma unroll
        for (int a = 0; a < 2; ++a)
#pragma unroll
            for (int b = 0; b < 2; ++b)
#pragma unroll
                for (int m = 0; m < 4; ++m)
#pragma unroll
                    for (int n = 0; n < 2; ++n) acc[a][b][m][n] = (f32x4){0.f, 0.f, 0.f, 0.f};
        cur = nxt; cA = nA; cB = nB; ++ui;
        if constexpr (ALIGN_EPI) { if (wr == 1) PG8_BAR; }
    }
    PG8_WAIT_V(0);
    if constexpr (!ALIGN_EPI) { if (wr == 0) PG8_BAR; }
    PG8_BAR;
    if constexpr (Epi::AFTER_DRAIN) { E.fused(acc, cur, wr, wc, fr, fq, lds, wid, lane); S.done(cur); }
#undef PG8_SA
#undef PG8_SB
#undef PG8_STAGE
#undef PG8_LDA
#undef PG8_LDB
#undef PG8_MMA
#undef PG8_WAIT_V
#undef PG8_WAIT_L
#undef PG8_BAR
#undef PG8_SCHED
}
}

constexpr int NWAVES = 8;
constexpr int BATCH = 32, SEQ = 2048, D = 1024, M = BATCH * SEQ;
constexpr int NQKV = 4608, RW_LD = 1792, LDW_IN = 9344;
constexpr int N1 = 6400, N2 = 3072, WT1_ROWS = N1 + N2;
constexpr int OFF_ATTN_GATE = 4608, OFF_RWKV = 5120, OFF_RWKV_GATE = 6784, OFF_MERGE = 7296;
constexpr float RMS_EPS = 1e-6f, GN_EPS = 64e-5f;
constexpr float LOG2E = 1.4426950408889634f;

constexpr size_t MiB = 1u << 20;
constexpr size_t WS_CTL = 0, CTL_ZERO_BYTES = 1 * MiB;
constexpr size_t WS_WT1 = 2 * MiB, WS_WTA = 22 * MiB, WS_WTB = 23 * MiB, WS_WTO = 24 * MiB, WS_LSE = 26 * MiB;
constexpr size_t WS_H = 32 * MiB, WS_QKV = 160 * MiB, WS_RW = 736 * MiB, WS_END = 960 * MiB;
constexpr size_t WS_SGA = 160 * MiB, WS_SGB = 288 * MiB, WS_A1 = 416 * MiB, WS_A2 = 480 * MiB, WS_MG = 544 * MiB;
static_assert(WS_WT1 + (size_t)WT1_ROWS * D * 2 <= WS_WTA && WS_LSE + (size_t)3 * M * 8 * 4 <= WS_H && WS_H + (size_t)M * D * 2 <= WS_QKV && WS_QKV + (size_t)M * NQKV * 2 <= WS_RW && WS_RW + (size_t)M * RW_LD * 2 <= WS_END && WS_MG + (size_t)M * D * 2 <= WS_RW, "d_ws map");
constexpr size_t OUT_OA = 0, OUT_OR = 64 * MiB;
constexpr int CW_BAR = 4096;

constexpr int RING_BYTES = 131072;
constexpr int LDS_BYTES = 163840;
constexpr int LDSCTL_OFF = LDS_BYTES - 2048, MISC_OFF = LDSCTL_OFF + 320, SS_OFF = MISC_OFF + 128;
static_assert(SS_OFF + 1024 <= LDS_BYTES, "LDS map");

#define GAS __attribute__((address_space(1)))
#define LAS __attribute__((address_space(3)))
typedef unsigned short bf16;
typedef unsigned v4u __attribute__((ext_vector_type(4)));
typedef unsigned v2u __attribute__((ext_vector_type(2)));
typedef float f32x4 __attribute__((ext_vector_type(4)));
typedef short bf16x8 __attribute__((ext_vector_type(8)));
typedef short s16x4 __attribute__((ext_vector_type(4)));
typedef GAS unsigned gu32;
#define LDS_WAIT() asm volatile("s_waitcnt lgkmcnt(0)" ::: "memory")
#define VM_WAIT() asm volatile("s_waitcnt vmcnt(0)" ::: "memory")
__device__ __forceinline__ unsigned f2bf(float f) { unsigned u = __builtin_bit_cast(unsigned, f); return (u + 0x7fffu + ((u >> 16) & 1u)) >> 16; }
__device__ __forceinline__ unsigned pk2(float lo, float hi) { return f2bf(lo) | (f2bf(hi) << 16); }
__device__ __forceinline__ float bflo(unsigned w) { return __builtin_bit_cast(float, w << 16); }
__device__ __forceinline__ float bfhi(unsigned w) { return __builtin_bit_cast(float, w & 0xffff0000u); }
template <int CTRL> __device__ __forceinline__ float dpp_f(float v) { return __builtin_bit_cast(float, __builtin_amdgcn_update_dpp(0, __builtin_bit_cast(int, v), CTRL, 0xF, 0xF, false)); }
__device__ __forceinline__ float sum4(float v) { v += dpp_f<0xB1>(v); v += dpp_f<0x4E>(v); return v; }
__device__ __forceinline__ float sum8(float v) { v = sum4(v); v += dpp_f<0x141>(v); return v; }
__device__ __forceinline__ float sum16(float v) { v = sum8(v); v += dpp_f<0x140>(v); return v; }
__device__ __forceinline__ float max16(float v) { v = fmaxf(v, dpp_f<0xB1>(v)); v = fmaxf(v, dpp_f<0x4E>(v)); v = fmaxf(v, dpp_f<0x141>(v)); v = fmaxf(v, dpp_f<0x140>(v)); return v; }
typedef float f32x2_t __attribute__((ext_vector_type(2)));
typedef __bf16 bf16x2_t __attribute__((ext_vector_type(2)));
__device__ __forceinline__ unsigned cvt2(float lo, float hi) { f32x2_t v = {lo, hi}; bf16x2_t b = __builtin_convertvector(v, bf16x2_t); return __builtin_bit_cast(unsigned, b); }
__device__ __forceinline__ void store_pairs(LAS unsigned char* base, int stride, float v0, float v1, float v2, float v3, bool odd) {
    const float y0 = dpp_f<0xB1>(odd ? v0 : v2), y1 = dpp_f<0xB1>(odd ? v1 : v3);
    const unsigned d0 = cvt2(odd ? y0 : v0, odd ? v2 : y0), d1 = cvt2(odd ? y1 : v1, odd ? v3 : y1);
    LAS unsigned char* p = base + (odd ? 2 * stride : 0);
    *(LAS unsigned*)p = d0; *(LAS unsigned*)(p + stride) = d1;
}
__device__ __forceinline__ void swap16(float& a, float& b) { asm volatile("s_nop 1\n\tv_permlane16_swap_b32 %0, %1\n\ts_nop 1" : "+v"(a), "+v"(b)); }
__device__ __forceinline__ void swap32(float& a, float& b) { asm volatile("s_nop 1\n\tv_permlane32_swap_b32 %0, %1\n\ts_nop 1" : "+v"(a), "+v"(b)); }
__device__ __forceinline__ float rows_max(float v) { float a = v, b = v; swap16(a, b); v = fmaxf(a, b); a = v; b = v; swap32(a, b); return fmaxf(a, b); }
__device__ __forceinline__ float rows_sum(float v) { float a = v, b = v; swap16(a, b); v = a + b; a = v; b = v; swap32(a, b); return a + b; }
template <int N> __device__ __forceinline__ float row_shr(float v, float fill) { return __builtin_bit_cast(float, __builtin_amdgcn_update_dpp(__builtin_bit_cast(int, fill), __builtin_bit_cast(int, v), 0x110 + N, 0xF, 0xF, false)); }
__device__ __forceinline__ float sigm(float z) { return __builtin_amdgcn_rcpf(1.0f + __builtin_amdgcn_exp2f(-LOG2E * z)); }

#ifndef TSPROBE
#define TSPROBE -1
#endif
#ifndef TSP_A
#define TSP_A TSPROBE
#define TSP_B (TSPROBE + 1)
#define TSP_DA 0
#define TSP_DB 6
#endif
#if TSPROBE >= 0
#define TS_MARK(k) do { if (blockIdx.x == 0 && threadIdx.x == 0) __hip_atomic_store((unsigned long long*)(F.ctl + 131072) + (k), (unsigned long long)__builtin_amdgcn_s_memrealtime(), __ATOMIC_RELAXED, __HIP_MEMORY_SCOPE_AGENT); } while (0)
#else
#define TS_MARK(k) do { } while (0)
#endif
#define XB_TMO      128
#define XB_XCNT(j)  (256  + 64 * (j))
#define XB_XSUB(j)  (1280 + 64 * (j))
#define XB_XGEN(j)  (2304 + 64 * (j))
#define XB_TOP      3328
#define XB_TOPGEN   3392
#define XCD_BAR_WORDS 3456
#define XB_SPIN_CAP (1u << 18)

__device__ __forceinline__ unsigned xb_ld(unsigned* p)              { return __hip_atomic_load(p, __ATOMIC_RELAXED, __HIP_MEMORY_SCOPE_AGENT); }
__device__ __forceinline__ unsigned xb_add(unsigned* p, unsigned v) { return __hip_atomic_fetch_add(p, v, __ATOMIC_RELAXED, __HIP_MEMORY_SCOPE_AGENT); }
__device__ __forceinline__ unsigned xb_xcc_id() { return (unsigned)__builtin_amdgcn_s_getreg((3 << 11) | 20) & 0xFu; }
#define XB_SPIN(cond, bar) do { unsigned _sp = 0; while (cond) { __builtin_amdgcn_s_sleep(1); \
    if ((++_sp & 255u) == 0u) { if (xb_ld(&(bar)[XB_TMO])) break; if (_sp > XB_SPIN_CAP) { atomicAdd(&(bar)[XB_TMO], 1u); break; } } } } while (0)

struct XcdBarrier {
    unsigned* bar; unsigned x;
    volatile LAS unsigned* st;
};

__device__ __forceinline__ XcdBarrier xcd_barrier_post(unsigned* bar, volatile LAS unsigned* st) {
    XcdBarrier b; b.bar = bar; b.x = xb_xcc_id(); b.st = st;
    if (threadIdx.x == 0) (void)xb_add(&bar[XB_XCNT(b.x)], 1u);
    return b;
}
__device__ __forceinline__ void xcd_barrier_complete(unsigned* bar, unsigned x, unsigned& nloc, unsigned& nx) {
    const unsigned G = gridDim.x * gridDim.y * gridDim.z;
    unsigned sum, cnt, mine, sp = 0u;
    for (;;) {
        sum = 0u; cnt = 0u; mine = 0u;
#pragma unroll
        for (unsigned j = 0; j < 16; ++j) { const unsigned c = xb_ld(&bar[XB_XCNT(j)]); sum += c; cnt += (c > 0u) ? 1u : 0u; mine = (j == x) ? c : mine; }
        if (sum == G) break;
        __builtin_amdgcn_s_sleep(1);
        if ((++sp & 255u) == 0u) { if (xb_ld(&bar[XB_TMO])) break; if (sp > XB_SPIN_CAP) { atomicAdd(&bar[XB_TMO], 1u); break; } }
    }
    nloc = mine > 0u ? mine : 1u; nx = cnt > 0u ? cnt : 1u;
}

__device__ __forceinline__ void xcd_barrier(const XcdBarrier& b) {
    asm volatile("s_waitcnt vmcnt(0)" ::: "memory");
    __syncthreads();
    if (threadIdx.x == 0) {
        unsigned* bar = b.bar;
        __builtin_amdgcn_s_waitcnt(0);
        unsigned nloc = b.st[0], nx = b.st[1];
        if (nloc == 0u) { xcd_barrier_complete(bar, b.x, nloc, nx); b.st[0] = nloc; b.st[1] = nx; }
        const unsigned old = xb_add(&bar[XB_XSUB(b.x)], 1u);
        const unsigned gen = old / nloc;
        if (old + 1u == (gen + 1u) * nloc) {
            __builtin_amdgcn_fence(__ATOMIC_RELEASE, "agent");
            asm volatile("s_waitcnt vmcnt(0)" ::: "memory");
            const unsigned og = xb_add(&bar[XB_TOP], 1u);
            const unsigned tg = og / nx;
            if (og + 1u == (tg + 1u) * nx) xb_add(&bar[XB_TOPGEN], 1u);
            else XB_SPIN(xb_ld(&bar[XB_TOPGEN]) == tg, bar);
            __builtin_amdgcn_fence(__ATOMIC_ACQUIRE, "agent");
            xb_add(&bar[XB_XGEN(b.x)], 1u);
            asm volatile("s_waitcnt vmcnt(0)" ::: "memory");
        } else {
            XB_SPIN(xb_ld(&bar[XB_XGEN(b.x)]) == gen, bar);
            __builtin_amdgcn_fence(__ATOMIC_ACQUIRE, "agent");
            asm volatile("s_waitcnt vmcnt(0)" ::: "memory");
        }
    }
    __syncthreads();
}

struct Frame {
    LAS unsigned char* lds;
    volatile LAS unsigned* MISC;
    gu32* ctl;
    int tid, lane, wave;
    int vcu, G;
    const float* x; float* out;
    const float *pre_g, *w_in, *rel_bias, *mix, *w0, *w_up, *a0, *a_up, *k_k, *k_a, *r_k, *ln_w, *ln_b, *w_upA, *w_upB, *w_out, *post_g;
    bf16 *WT1, *WTA, *WTB, *WTO, *H, *QKV, *RW, *SGA, *SGB, *A1, *A2, *MG, *OA, *OR;
    float* LSE;
};

__device__ __forceinline__ float wave_sum(float v) {
#pragma unroll
    for (int o = 1; o < 64; o <<= 1) v += __shfl_xor(v, o);
    return v;
}
__device__ __forceinline__ void p0_transpose_item(const float* W, int K, int ldw, int c0, int nblk, bf16* WT, int row_off, LAS float* scr, int item, int lane) {
    const int kb = item / nblk, nb = item % nblk, k0 = 64 * kb, n0 = 32 * nb;
#pragma unroll 8
    for (int i = 0; i < 32; ++i) { const int kk = 2 * i + (lane >> 5); scr[kk * 33 + (lane & 31)] = W[(size_t)(k0 + kk) * ldw + c0 + n0 + (lane & 31)]; }
    LDS_WAIT(); asm volatile("" ::: "memory");
    const int c = lane & 7;
#pragma unroll
    for (int j = 0; j < 4; ++j) { const int n = (lane >> 3) + 8 * j; const LAS float* s = scr + (8 * c) * 33 + n;
        v4u o; o.x = pk2(s[0 * 33], s[1 * 33]); o.y = pk2(s[2 * 33], s[3 * 33]); o.z = pk2(s[4 * 33], s[5 * 33]); o.w = pk2(s[6 * 33], s[7 * 33]);
        *(GAS v4u*)(WT + (size_t)(row_off + n0 + n) * K + k0 + 8 * c) = o; }
    LDS_WAIT(); asm volatile("" ::: "memory");
}
__device__ __forceinline__ void rms_row_to_bf16(Frame& F, const float* xrow, bf16* orow) {
    const GAS f32x4* xr = (const GAS f32x4*)xrow + F.lane; const GAS f32x4* gr = (const GAS f32x4*)F.pre_g + F.lane;
    f32x4 v[4]; float s = 0.f;
#pragma unroll
    for (int j = 0; j < 4; ++j) { v[j] = xr[64 * j]; s += (v[j].x * v[j].x + v[j].y * v[j].y) + (v[j].z * v[j].z + v[j].w * v[j].w); }
    const float rstd = 1.f / sqrtf(wave_sum(s) * (1.f / D) + RMS_EPS);
    GAS unsigned long long* o8 = (GAS unsigned long long*)orow + F.lane;
#pragma unroll
    for (int j = 0; j < 4; ++j) { const f32x4 g = gr[64 * j]; const f32x4 y = v[j] * rstd * g;
        o8[64 * j] = (unsigned long long)pk2(y.x, y.y) | ((unsigned long long)pk2(y.z, y.w) << 32); }
}
__device__ __forceinline__ void p0_prologue(Frame& F) {
    LAS float* scr = (LAS float*)(F.lds + F.wave * 16384);
    const int gw = F.vcu * NWAVES + F.wave, NGW = F.G * NWAVES;
    constexpr int I1 = 16 * 144, I2 = 16 * 52, I4 = 16 * 16, I5 = 16 * 16, I6 = 16 * 64, I7 = 8 * 32, I8 = 8 * 32, I9 = 16 * 32;
    constexpr int NITEMS = I1 + I2 + I4 + I5 + I6 + I7 + I8 + I9;
    for (int it = gw; it < NITEMS; it += NGW) {
        int r = it;
        if (r < I1) { p0_transpose_item(F.w_in, D, LDW_IN, 0, 144, F.WT1, 0, scr, r, F.lane); continue; } r -= I1;
        if (r < I2) { p0_transpose_item(F.w_in, D, LDW_IN, OFF_RWKV, 52, F.WT1, 4608, scr, r, F.lane); continue; } r -= I2;
        if (r < I4) { p0_transpose_item(F.w_in, D, LDW_IN, OFF_ATTN_GATE, 16, F.WT1, N1, scr, r, F.lane); continue; } r -= I4;
        if (r < I5) { p0_transpose_item(F.w_in, D, LDW_IN, OFF_RWKV_GATE, 16, F.WT1, N1 + 512, scr, r, F.lane); continue; } r -= I5;
        if (r < I6) { p0_transpose_item(F.w_in, D, LDW_IN, OFF_MERGE, 64, F.WT1, N1 + 1024, scr, r, F.lane); continue; } r -= I6;
        if (r < I7) { p0_transpose_item(F.w_upA, 512, D, 0, 32, F.WTA, 0, scr, r, F.lane); continue; } r -= I7;
        if (r < I8) { p0_transpose_item(F.w_upB, 512, D, 0, 32, F.WTB, 0, scr, r, F.lane); continue; } r -= I8;
        p0_transpose_item(F.w_out, D, D, 0, 32, F.WTO, 0, scr, r, F.lane);
    }
    { const int gt = F.vcu * (NWAVES * 64) + F.tid, NT = F.G * NWAVES * 64;
      for (int i = gt; i < 16384; i += NT) *((GAS v4u*)(F.WT1 + (size_t)6272 * D) + i) = (v4u){0u, 0u, 0u, 0u}; }
    for (int m = gw; m < M; m += NGW) rms_row_to_bf16(F, F.x + (size_t)m * D, F.H + (size_t)m * D);
}

namespace att {
constexpr int KSTR = 144;
constexpr int HALF_B = 128 * KSTR;
constexpr int KS_OFF = 0, VS_OFF = 3 * HALF_B, OST_OFF = 6 * HALF_B, OST_WAVE = 16 * KSTR, LST_OFF = OST_OFF + 8 * OST_WAVE, BIAS_OFF = LST_OFF + 8 * 64, END_OFF = BIAS_OFF + 3 * 544;
static_assert(END_OFF <= LDSCTL_OFF, "attention LDS");
typedef short v4i16_t __attribute__((ext_vector_type(4)));
__device__ __forceinline__ s16x4 vtr(LAS const unsigned char* p) { return __builtin_bit_cast(s16x4, __builtin_amdgcn_ds_read_tr16_b64_v4i16((LAS v4i16_t*)p)); }
__device__ __forceinline__ int t5_bucket(int d) {
    if (d < 16) return d;
    int b = 16;
    b += (d >= 22); b += (d >= 30); b += (d >= 40); b += (d >= 54); b += (d >= 73); b += (d >= 99); b += (d >= 134); b += (d >= 182);
    b += (d >= 246); b += (d >= 332); b += (d >= 450); b += (d >= 609); b += (d >= 825); b += (d >= 1117); b += (d >= 1513);
    return b;
}
__device__ __forceinline__ void blk_decode(int i, int& g, int& dil, int& r, int& n) {
    if (i < 16) { g = 0; dil = 1; r = 0; n = i; } else if (i < 32) { g = 1; dil = 4; r = (i - 16) >> 2; n = (i - 16) & 3; } else { g = 2; dil = 16; r = i - 32; n = 0; }
}

__device__ __forceinline__ void attn_phase(Frame& F) {
    LAS unsigned char* lds = F.lds;
    const int tid = F.tid, lane = F.lane, w = F.wave, c = lane & 15, q = lane >> 4;
    const int b = F.vcu >> 3, h = F.vcu & 7;
    if (F.vcu >= BATCH * 8) return;
    const float NEG_INF = -__builtin_inff();
    __syncthreads();
    for (int i = tid; i < 3 * 129; i += NWAVES * 64) { const int g = i / 129, rel = i % 129, dil = (g == 0) ? 1 : (g == 1) ? 4 : 16;
        ((LAS float*)(lds + BIAS_OFF + g * 544))[rel] = F.rel_bias[t5_bucket(rel * dil) * 24 + g * 8 + h] * LOG2E; }
    for (int i = tid; i < 6 * HALF_B / 16; i += NWAVES * 64) *(LAS v4u*)(lds + i * 16) = (v4u){0u, 0u, 0u, 0u};
    const bf16* Qb = F.QKV + (size_t)b * SEQ * NQKV + h * 64;
    LAS unsigned char* OSTw = lds + OST_OFF + w * OST_WAVE;
    LAS float* LSTw = (LAS float*)(lds + LST_OFF + w * 64);
    const int srow0 = tid >> 3, sch = tid & 7;
    v4u kreg[2], vreg[2]; bf16x8 aq[2];
#define ATT_LOAD(i) do { int g_, dil_, r_, n_; blk_decode((i), g_, dil_, r_, n_); const bf16* Qg_ = Qb + g_ * 512; \
        _Pragma("unroll") for (int it = 0; it < 2; ++it) { const bf16* p_ = Qg_ + (size_t)((n_ * 128 + srow0 + 64 * it) * dil_ + r_) * NQKV + sch * 8; kreg[it] = *(const GAS v4u*)(p_ + 1536); vreg[it] = *(const GAS v4u*)(p_ + 3072); } \
        { const bf16* qp_ = Qg_ + (size_t)((n_ * 128 + 16 * w + c) * dil_ + r_) * NQKV + 8 * q; aq[0] = *(const GAS bf16x8*)(qp_); aq[1] = *(const GAS bf16x8*)(qp_ + 32); } } while (0)
#define ATT_STORE(slot) do { _Pragma("unroll") for (int it = 0; it < 2; ++it) { const int o_ = (slot) * HALF_B + (srow0 + 64 * it) * KSTR + sch * 16; *(LAS v4u*)(lds + KS_OFF + o_) = kreg[it]; *(LAS v4u*)(lds + VS_OFF + o_) = vreg[it]; } } while (0)
    ATT_LOAD(0);
    __syncthreads();
    ATT_STORE(0);
    bf16x8 aqc[2] = {aq[0], aq[1]};
    __syncthreads();
    float bl[9][4];
    int gprev = -1;
#pragma unroll 1
    for (int i = 0; i < 48; ++i) {
        int g, dil, r, n; blk_decode(i, g, dil, r, n);
        const int cur = i % 3, prv = (i + 2) % 3;
        ATT_LOAD((i + 1 < 48) ? i + 1 : i);
        if (g != gprev) { gprev = g; const LAS float* bias2 = (const LAS float*)(lds + BIAS_OFF + g * 544);
#pragma unroll
            for (int n16 = 0; n16 < 9; ++n16)
#pragma unroll
                for (int reg = 0; reg < 4; ++reg) { const int rel = 128 + c - 16 * n16 - 4 * q - reg; const int rc = rel < 0 ? 0 : (rel > 128 ? 128 : rel);
                    const float bv = bias2[rc]; bl[n16][reg] = (rel >= 0 && rel <= 128) ? bv : NEG_INF; } }
        f32x4 s[9]; float mx = NEG_INF;
#pragma unroll
        for (int n16 = 0; n16 < 9; ++n16) { const int kpos0 = 16 * w + 16 * n16; const int rowb = ((kpos0 >= 128) ? cur : prv) * 128 + (kpos0 & 127);
            f32x4 a = (f32x4){0.f, 0.f, 0.f, 0.f};
#pragma unroll
            for (int ks = 0; ks < 2; ++ks) { const bf16x8 kf = *(const LAS bf16x8*)(lds + KS_OFF + (rowb + c) * KSTR + (32 * ks + 8 * q) * 2);
                a = __builtin_amdgcn_mfma_f32_16x16x32_bf16(kf, aqc[ks], a, 0, 0, 0); }
            const bool ok = (n > 0) || (kpos0 >= 128);
#pragma unroll
            for (int reg = 0; reg < 4; ++reg) { const float v = ok ? a[reg] + bl[n16][reg] : NEG_INF; a[reg] = v; mx = fmaxf(mx, v); }
            s[n16] = a; }
        mx = rows_max(mx);
        float ls = 0.f; s16x4 pb[9];
#pragma unroll
        for (int n16 = 0; n16 < 9; ++n16) { const float p0 = __builtin_amdgcn_exp2f(s[n16][0] - mx), p1 = __builtin_amdgcn_exp2f(s[n16][1] - mx), p2 = __builtin_amdgcn_exp2f(s[n16][2] - mx), p3 = __builtin_amdgcn_exp2f(s[n16][3] - mx);
            ls += (p0 + p1) + (p2 + p3); v2u pk; pk.x = cvt2(p0, p1); pk.y = cvt2(p2, p3); pb[n16] = __builtin_bit_cast(s16x4, pk); }
        ls = rows_sum(ls);
        f32x4 o[4];
#pragma unroll
        for (int nd = 0; nd < 4; ++nd) o[nd] = (f32x4){0.f, 0.f, 0.f, 0.f};
#pragma unroll
        for (int n16 = 0; n16 < 9; ++n16) { const int kpos0 = 16 * w + 16 * n16; const int rowb = ((kpos0 >= 128) ? cur : prv) * 128 + (kpos0 & 127);
            LAS const unsigned char* vb = lds + VS_OFF + (rowb + 4 * q + (c >> 2)) * KSTR + (c & 3) * 8;
#pragma unroll
            for (int nd = 0; nd < 4; ++nd) o[nd] = __builtin_amdgcn_mfma_f32_16x16x16bf16_1k(vtr(vb + nd * 32), pb[n16], o[nd], 0, 0, 0); }
        { const float inv = __builtin_amdgcn_rcpf(ls);
#pragma unroll
          for (int nd = 0; nd < 4; ++nd) { v2u pk; pk.x = cvt2(o[nd][0] * inv, o[nd][1] * inv); pk.y = cvt2(o[nd][2] * inv, o[nd][3] * inv); *(LAS v2u*)(OSTw + c * KSTR + (16 * nd + 4 * q) * 2) = pk; } }
        const bf16* Qg = Qb + g * 512;
#pragma unroll
        for (int it = 0; it < 2; ++it) { const int id = lane + 64 * it, row = id >> 3, ch = id & 7;
            const v4u val = *(const LAS v4u*)(OSTw + row * KSTR + ch * 16);
            *(GAS v4u*)(Qg + (size_t)((n * 128 + 16 * w + row) * dil + r) * NQKV + ch * 8) = val; }
        if (q == 0) F.LSE[((size_t)g * M + (size_t)b * SEQ + (size_t)((n * 128 + 16 * w + c) * dil + r)) * 8 + h] = mx + __builtin_amdgcn_logf(ls);
        ATT_STORE((i + 1) % 3); aqc[0] = aq[0]; aqc[1] = aq[1];
        __syncthreads();
    }
#undef ATT_LOAD
#undef ATT_STORE
    VM_WAIT(); __syncthreads();
    if (tid == 0) { __builtin_amdgcn_fence(__ATOMIC_ACQUIRE, "agent"); VM_WAIT(); }
    __syncthreads();
    for (int p = tid; p < SEQ * 8; p += NWAVES * 64) { const int t = p >> 3, ch = p & 7; const size_t row = (size_t)b * SEQ + t;
        float l0 = F.LSE[((size_t)0 * M + row) * 8 + h], l1 = F.LSE[((size_t)1 * M + row) * 8 + h], l2 = F.LSE[((size_t)2 * M + row) * 8 + h];
        const float mm = fmaxf(l0, fmaxf(l1, l2)); float w0 = __builtin_amdgcn_exp2f(l0 - mm), w1 = __builtin_amdgcn_exp2f(l1 - mm), w2 = __builtin_amdgcn_exp2f(l2 - mm);
        const float wi = __builtin_amdgcn_rcpf(w0 + w1 + w2); w0 *= wi; w1 *= wi; w2 *= wi;
        const bf16* qp = F.QKV + row * NQKV + h * 64 + ch * 8;
        const v4u a = *(const GAS v4u*)(qp), bb = *(const GAS v4u*)(qp + 512), cc = *(const GAS v4u*)(qp + 1024);
        v4u o;
        o.x = pk2(w0 * bflo(a.x) + w1 * bflo(bb.x) + w2 * bflo(cc.x), w0 * bfhi(a.x) + w1 * bfhi(bb.x) + w2 * bfhi(cc.x));
        o.y = pk2(w0 * bflo(a.y) + w1 * bflo(bb.y) + w2 * bflo(cc.y), w0 * bfhi(a.y) + w1 * bfhi(bb.y) + w2 * bfhi(cc.y));
        o.z = pk2(w0 * bflo(a.z) + w1 * bflo(bb.z) + w2 * bflo(cc.z), w0 * bfhi(a.z) + w1 * bfhi(bb.z) + w2 * bfhi(cc.z));
        o.w = pk2(w0 * bflo(a.w) + w1 * bflo(bb.w) + w2 * bflo(cc.w), w0 * bfhi(a.w) + w1 * bfhi(bb.w) + w2 * bfhi(cc.w));
        *(GAS v4u*)(F.OA + row * 512 + h * 64 + ch * 8) = o; }
    __syncthreads();
}
}

namespace rwkv {
constexpr int TC = 64, RSTR = 144;
constexpr int YSTR = 68;
constexpr int WUPT_OFF = 0, AUPT_OFF = 9216, TW_OFF = 18432, AL_OFF = 27648, RB_OFF = 36864, Y_OFF = 64512;
constexpr int AT_OFF = Y_OFF + 64 * YSTR * 4, RT_OFF = AT_OFF + 9216, BT_OFF = RT_OFF + 9216, KT_OFF = BT_OFF + 9216, VV_OFF = KT_OFF + 9216;
constexpr int MK_OFF = VV_OFF + 9216, PB_OFF = MK_OFF + 2048, PK_OFF = PB_OFF + 2048, TT_OFF = PK_OFF + 2048, GAM_OFF = TT_OFF + 2048, XS_OFF = GAM_OFF + 1024, SSQ_OFF = XS_OFF + 4096, CONST_OFF = SSQ_OFF + 256, END_OFF = CONST_OFF + 2304;
static_assert(END_OFF <= LDSCTL_OFF, "scan LDS");
typedef short v4i16_t __attribute__((ext_vector_type(4)));
__device__ __forceinline__ s16x4 vtr(LAS const unsigned char* p) { return __builtin_bit_cast(s16x4, __builtin_amdgcn_ds_read_tr16_b64_v4i16((LAS v4i16_t*)p)); }
__device__ __forceinline__ s16x4 pack4(const f32x4& x) { v2u p; p.x = cvt2(x[0], x[1]); p.y = cvt2(x[2], x[3]); return __builtin_bit_cast(s16x4, p); }
#define MFMA16(a, b, c) __builtin_amdgcn_mfma_f32_16x16x16bf16_1k((a), (b), (c), 0, 0, 0)
#define MFMA32(a, b, c) __builtin_amdgcn_mfma_f32_16x16x32_bf16((a), (b), (c), 0, 0, 0)

__device__ __forceinline__ void scan_phase(Frame& F) {
    LAS unsigned char* lds = F.lds;
    const int tid = F.tid, lane = F.lane, w = F.wave, c = lane & 15, q = lane >> 4;
    const int b = F.vcu >> 3, h = F.vcu & 7;
    if (F.vcu >= BATCH * 8) return;
    __syncthreads();
    for (int e = tid; e < 64 * 64; e += NWAVES * 64) { const int j = e >> 6, i = e & 63;
        *(LAS unsigned short*)(lds + WUPT_OFF + i * RSTR + j * 2) = (unsigned short)f2bf(F.w_up[j * 512 + h * 64 + i]);
        *(LAS unsigned short*)(lds + AUPT_OFF + i * RSTR + j * 2) = (unsigned short)f2bf(F.a_up[j * 512 + h * 64 + i]); }
    LAS float* Y = (LAS float*)(lds + Y_OFF);
    LAS float* GAM = (LAS float*)(lds + GAM_OFF);
    LAS float* SSQ = (LAS float*)(lds + SSQ_OFF);
    LAS float* CST = (LAS float*)(lds + CONST_OFF);
    if (tid < 320) { const int run = tid >> 6, i = tid & 63; CST[tid] = F.mix[(run < 3 ? run * 512 + h * 64 : (run == 3 ? 1536 : 1600)) + i]; }
    else if (tid < 384) CST[tid] = F.k_k[h * 64 + (tid - 320)];
    else if (tid < 448) CST[tid] = F.ln_w[h * 64 + (tid - 384)];
    else CST[tid] = F.ln_b[h * 64 + (tid - 448)];
    if (tid < 64) CST[512 + tid] = F.r_k[h * 64 + tid];
    const bf16* RWb = F.RW + (size_t)b * SEQ * RW_LD;
    v4u cur[5], prv[5];
#define PIECE(it) const int tok_ = tid >> 3, run_ = (it), pc_ = tid & 7, col_ = ((it) < 3 ? (it) * 512 + h * 64 : ((it) == 3 ? 1536 : 1600)) + pc_ * 8
#define RW_LOAD(t0) do { _Pragma("unroll") for (int it = 0; it < 5; ++it) { PIECE(it); const int t = (t0) + tok_; cur[it] = *(const GAS v4u*)(RWb + (size_t)t * RW_LD + col_); \
        prv[it] = (v4u){0u, 0u, 0u, 0u}; if (t > 0) prv[it] = *(const GAS v4u*)(RWb + (size_t)(t - 1) * RW_LD + col_); (void)run_; } } while (0)
    RW_LOAD(0);
    const int nt = w & 3, ich4 = 16 * nt + 4 * q, hc_e = h * 64 + ich4;
    const f32x4 p_w0s = *(const GAS f32x4*)(F.w0 + hc_e) * (-LOG2E), p_a0s = *(const GAS f32x4*)(F.a0 + hc_e) * (-LOG2E), p_kk = *(const GAS f32x4*)(F.k_k + hc_e), p_ka = *(const GAS f32x4*)(F.k_a + hc_e);
    const int otok = tid >> 3, opart = tid & 7, hc_o = h * 64 + 8 * opart;
    f32x4 ST[4];
#pragma unroll
    for (int n = 0; n < 4; ++n) ST[n] = (f32x4){0.f, 0.f, 0.f, 0.f};
    __syncthreads();
#define SCAN_OUT(tbase) do { \
        const f32x4 y0 = *(const LAS f32x4*)(Y + otok * YSTR + 8 * opart), y1 = *(const LAS f32x4*)(Y + otok * YSTR + 8 * opart + 4); \
        const v4u vb = *(const LAS v4u*)(lds + VV_OFF + otok * RSTR + opart * 16), rb = *(const LAS v4u*)(lds + RT_OFF + otok * RSTR + opart * 16), kb = *(const LAS v4u*)(lds + KT_OFF + otok * RSTR + opart * 16); \
        const f32x4 rk0 = *(const LAS f32x4*)(CST + 512 + 8 * opart), rk1 = *(const LAS f32x4*)(CST + 516 + 8 * opart); \
        const f32x4 lw0 = *(const LAS f32x4*)(CST + 384 + 8 * opart), lw1 = *(const LAS f32x4*)(CST + 388 + 8 * opart), lb0 = *(const LAS f32x4*)(CST + 448 + 8 * opart), lb1 = *(const LAS f32x4*)(CST + 452 + 8 * opart); \
        const f32x4 v0 = (f32x4){bflo(vb.x), bfhi(vb.x), bflo(vb.y), bfhi(vb.y)}, v1 = (f32x4){bflo(vb.z), bfhi(vb.z), bflo(vb.w), bfhi(vb.w)}; \
        const f32x4 r0 = (f32x4){bflo(rb.x), bfhi(rb.x), bflo(rb.y), bfhi(rb.y)}, r1 = (f32x4){bflo(rb.z), bfhi(rb.z), bflo(rb.w), bfhi(rb.w)}; \
        const f32x4 k0 = (f32x4){bflo(kb.x), bfhi(kb.x), bflo(kb.y), bfhi(kb.y)}, k1 = (f32x4){bflo(kb.z), bfhi(kb.z), bflo(kb.w), bfhi(kb.w)}; \
        const f32x4 z0 = r0 * k0 * rk0, z1 = r1 * k1 * rk1; \
        const float bon = sum8(((z0[0] + z0[1]) + (z0[2] + z0[3])) + ((z1[0] + z1[1]) + (z1[2] + z1[3]))); \
        const float mu = sum8(((y0[0] + y0[1]) + (y0[2] + y0[3])) + ((y1[0] + y1[1]) + (y1[2] + y1[3]))) * (1.0f / 64.0f); const f32x4 d0 = y0 - mu, d1 = y1 - mu; \
        const float var = sum8(((d0[0] * d0[0] + d0[1] * d0[1]) + (d0[2] * d0[2] + d0[3] * d0[3])) + ((d1[0] * d1[0] + d1[1] * d1[1]) + (d1[2] * d1[2] + d1[3] * d1[3]))) * (1.0f / 64.0f); \
        const float rs = __builtin_amdgcn_rsqf(var + GN_EPS); \
        const f32x4 o0 = d0 * rs * lw0 + lb0 + v0 * bon, o1 = d1 * rs * lw1 + lb1 + v1 * bon; \
        v4u ow; ow.x = cvt2(o0[0], o0[1]); ow.y = cvt2(o0[2], o0[3]); ow.z = cvt2(o1[0], o1[1]); ow.w = cvt2(o1[2], o1[3]); \
        *(GAS v4u*)(F.OR + ((size_t)b * SEQ + (tbase) + otok) * 512 + hc_o) = ow; } while (0)

    for (int t0 = 0; t0 < SEQ; t0 += TC) {
        if (t0 == 1024) TS_MARK(10);
        if (t0 > 0) SCAN_OUT(t0 - TC);
        { f32x4 mx0[5], mx1[5];
#pragma unroll
          for (int it = 0; it < 5; ++it) { mx0[it] = *(const LAS f32x4*)(CST + it * 64 + (tid & 7) * 8); mx1[it] = *(const LAS f32x4*)(CST + it * 64 + (tid & 7) * 8 + 4); }
          const f32x4 kk0 = *(const LAS f32x4*)(CST + 320 + (tid & 7) * 8), kk1 = *(const LAS f32x4*)(CST + 324 + (tid & 7) * 8);
#pragma unroll
          for (int it = 0; it < 5; ++it) { PIECE(it); (void)col_;
            float x[8];
            { const v4u cu = cur[it], pr = prv[it];
              const float cv[8] = {bflo(cu.x), bfhi(cu.x), bflo(cu.y), bfhi(cu.y), bflo(cu.z), bfhi(cu.z), bflo(cu.w), bfhi(cu.w)};
              const float pv[8] = {bflo(pr.x), bfhi(pr.x), bflo(pr.y), bfhi(pr.y), bflo(pr.z), bfhi(pr.z), bflo(pr.w), bfhi(pr.w)};
              const float mv[8] = {mx0[it][0], mx0[it][1], mx0[it][2], mx0[it][3], mx1[it][0], mx1[it][1], mx1[it][2], mx1[it][3]};
#pragma unroll
              for (int e = 0; e < 8; ++e) x[e] = cv[e] + (pv[e] - cv[e]) * mv[e]; }
            if (run_ == 1) { float s = 0.f;
#pragma unroll
                for (int e = 0; e < 4; ++e) { const float z0 = x[e] * kk0[e], z1 = x[4 + e] * kk1[e]; s += z0 * z0 + z1 * z1; }
                s = sum8(s); if (pc_ == 0) SSQ[tok_] = s; }
            if (run_ == 3) {
#pragma unroll
                for (int e = 0; e < 8; ++e) { const float ex = __builtin_amdgcn_exp2f(2.0f * LOG2E * x[e]); x[e] = 1.0f - 2.0f * __builtin_amdgcn_rcpf(ex + 1.0f); } }
            v4u o; o.x = cvt2(x[0], x[1]); o.y = cvt2(x[2], x[3]); o.z = cvt2(x[4], x[5]); o.w = cvt2(x[6], x[7]);
            *(LAS v4u*)(lds + (run_ < 3 ? RB_OFF + run_ * 9216 : (run_ == 3 ? TW_OFF : AL_OFF)) + tok_ * RSTR + pc_ * 16) = o;
          } }
        __syncthreads();
        if (t0 == 1024) TS_MARK(11);
        RW_LOAD((t0 + TC < SEQ) ? t0 + TC : t0);
        { f32x4 cw[2], ca[2]; v2u rraw[2], kraw[2], vraw[2]; float ssq[2];
#pragma unroll
          for (int half = 0; half < 2; ++half) { const int mt = 2 * (w >> 2) + half;
            cw[half] = (f32x4){0.f, 0.f, 0.f, 0.f}; ca[half] = (f32x4){0.f, 0.f, 0.f, 0.f};
#pragma unroll
            for (int ks = 0; ks < 2; ++ks) {
                const bf16x8 atw = *(const LAS bf16x8*)(lds + TW_OFF + (16 * mt + c) * RSTR + (32 * ks + 8 * q) * 2), aal = *(const LAS bf16x8*)(lds + AL_OFF + (16 * mt + c) * RSTR + (32 * ks + 8 * q) * 2);
                const bf16x8 bw = *(const LAS bf16x8*)(lds + WUPT_OFF + (16 * nt + c) * RSTR + (32 * ks + 8 * q) * 2), ba = *(const LAS bf16x8*)(lds + AUPT_OFF + (16 * nt + c) * RSTR + (32 * ks + 8 * q) * 2);
                cw[half] = MFMA32(bw, atw, cw[half]); ca[half] = MFMA32(ba, aal, ca[half]); }
            const int off = (16 * mt + c) * RSTR + ich4 * 2;
            rraw[half] = *(const LAS v2u*)(lds + RB_OFF + off); kraw[half] = *(const LAS v2u*)(lds + RB_OFF + 9216 + off); vraw[half] = *(const LAS v2u*)(lds + RB_OFF + 18432 + off);
            ssq[half] = SSQ[16 * mt + c]; }
#pragma unroll
          for (int half = 0; half < 2; ++half) { const int mt = 2 * (w >> 2) + half;
            const float isq = __builtin_amdgcn_rsqf(fmaxf(ssq[half], 1e-24f));
            const float rr[4] = {bflo(rraw[half].x), bfhi(rraw[half].x), bflo(rraw[half].y), bfhi(rraw[half].y)}, kr[4] = {bflo(kraw[half].x), bfhi(kraw[half].x), bflo(kraw[half].y), bfhi(kraw[half].y)};
            float oa[4], orr[4], ob[4], ok[4], gl[4];
#pragma unroll
            for (int reg = 0; reg < 4; ++reg) {
                const float sg = __builtin_amdgcn_rcpf(1.0f + __builtin_amdgcn_exp2f(__builtin_fmaf(cw[half][reg], -LOG2E, p_w0s[reg])));
                float P = __builtin_amdgcn_exp2f(-0.6065306597126334f * LOG2E * sg);
                const float al = __builtin_amdgcn_rcpf(1.0f + __builtin_amdgcn_exp2f(__builtin_fmaf(ca[half][reg], -LOG2E, p_a0s[reg])));
                const float kkn = kr[reg] * p_kk[reg] * isq;
                const float kp = kr[reg] * __builtin_fmaf(al, p_ka[reg], 1.0f - p_ka[reg]);
                P *= row_shr<1>(P, 1.0f); P *= row_shr<2>(P, 1.0f); P *= row_shr<4>(P, 1.0f); P *= row_shr<8>(P, 1.0f);
                const float gM = row_shr<1>(P, 1.0f), gN = __builtin_amdgcn_rcpf(P);
                oa[reg] = -kkn * gM; orr[reg] = rr[reg] * P; ob[reg] = kkn * al * gN; ok[reg] = kp * gN; gl[reg] = P; }
            const int off = (16 * mt + c) * RSTR + ich4 * 2;
            { v2u o; o.x = cvt2(oa[0], oa[1]); o.y = cvt2(oa[2], oa[3]); *(LAS v2u*)(lds + AT_OFF + off) = o; }
            { v2u o; o.x = cvt2(orr[0], orr[1]); o.y = cvt2(orr[2], orr[3]); *(LAS v2u*)(lds + RT_OFF + off) = o; }
            { v2u o; o.x = cvt2(ob[0], ob[1]); o.y = cvt2(ob[2], ob[3]); *(LAS v2u*)(lds + BT_OFF + off) = o; }
            { v2u o; o.x = cvt2(ok[0], ok[1]); o.y = cvt2(ok[2], ok[3]); *(LAS v2u*)(lds + KT_OFF + off) = o; }
            *(LAS v2u*)(lds + VV_OFF + off) = vraw[half];
            if (c == 15) *(LAS f32x4*)(GAM + mt * 64 + ich4) = (f32x4){gl[0], gl[1], gl[2], gl[3]}; } }
        __syncthreads();
        if (t0 == 1024) TS_MARK(12);
        { const int ch = w & 3, tk0 = 16 * ch;
          const bf16x8 aA0 = *(const LAS bf16x8*)(lds + AT_OFF + (tk0 + c) * RSTR + (8 * q) * 2), aA1 = *(const LAS bf16x8*)(lds + AT_OFF + (tk0 + c) * RSTR + (32 + 8 * q) * 2);
          const f32x4 zero4 = (f32x4){0.f, 0.f, 0.f, 0.f};
          if (w < 4) {
              const bf16x8 bB0 = *(const LAS bf16x8*)(lds + BT_OFF + (tk0 + c) * RSTR + (8 * q) * 2), bB1 = *(const LAS bf16x8*)(lds + BT_OFF + (tk0 + c) * RSTR + (32 + 8 * q) * 2);
              f32x4 X = MFMA32(aA0, bB0, zero4); X = MFMA32(aA1, bB1, X);
              LAS unsigned char* xs = lds + XS_OFF + w * 512;
              store_pairs(xs + (4 * q) * 32 + (c & ~1) * 2, 32, (c < 4 * q + 0) ? X[0] : 0.f, (c < 4 * q + 1) ? X[1] : 0.f, (c < 4 * q + 2) ? X[2] : 0.f, (c < 4 * q + 3) ? X[3] : 0.f, c & 1);
              const s16x4 aX = *(const LAS s16x4*)(xs + c * 32 + 8 * q);
              f32x4 I4;
#pragma unroll
              for (int reg = 0; reg < 4; ++reg) I4[reg] = (4 * q + reg == c) ? 1.f : 0.f;
              f32x4 Tt = I4;
#pragma unroll
              for (int it = 0; it < 15; ++it) Tt = MFMA16(aX, pack4(Tt), I4);
              store_pairs(lds + TT_OFF + ch * 512 + (4 * q) * 32 + (c & ~1) * 2, 32, Tt[0], Tt[1], Tt[2], Tt[3], c & 1);
          } else {
              const bf16x8 aR0 = *(const LAS bf16x8*)(lds + RT_OFF + (tk0 + c) * RSTR + (8 * q) * 2), aR1 = *(const LAS bf16x8*)(lds + RT_OFF + (tk0 + c) * RSTR + (32 + 8 * q) * 2);
              const bf16x8 bB0 = *(const LAS bf16x8*)(lds + BT_OFF + (tk0 + c) * RSTR + (8 * q) * 2), bB1 = *(const LAS bf16x8*)(lds + BT_OFF + (tk0 + c) * RSTR + (32 + 8 * q) * 2);
              const bf16x8 bK0 = *(const LAS bf16x8*)(lds + KT_OFF + (tk0 + c) * RSTR + (8 * q) * 2), bK1 = *(const LAS bf16x8*)(lds + KT_OFF + (tk0 + c) * RSTR + (32 + 8 * q) * 2);
              f32x4 mk = MFMA32(aA0, bK0, zero4); mk = MFMA32(aA1, bK1, mk);
              f32x4 pb = MFMA32(aR0, bB0, zero4); pb = MFMA32(aR1, bB1, pb);
              f32x4 pk = MFMA32(aR0, bK0, zero4); pk = MFMA32(aR1, bK1, pk);
              { const int o = ch * 512 + (4 * q) * 32 + (c & ~1) * 2; const int t_ = 4 * q;
                store_pairs(lds + MK_OFF + o, 32, (c < t_) ? mk[0] : 0.f, (c < t_ + 1) ? mk[1] : 0.f, (c < t_ + 2) ? mk[2] : 0.f, (c < t_ + 3) ? mk[3] : 0.f, c & 1);
                store_pairs(lds + PB_OFF + o, 32, (c <= t_) ? pb[0] : 0.f, (c <= t_ + 1) ? pb[1] : 0.f, (c <= t_ + 2) ? pb[2] : 0.f, (c <= t_ + 3) ? pb[3] : 0.f, c & 1);
                store_pairs(lds + PK_OFF + o, 32, (c <= t_) ? pk[0] : 0.f, (c <= t_ + 1) ? pk[1] : 0.f, (c <= t_ + 2) ? pk[2] : 0.f, (c <= t_ + 3) ? pk[3] : 0.f, c & 1); }
          } }
        __syncthreads();
        if (t0 == 1024) TS_MARK(13);
        if (w < 4) { f32x4 YT4[4];
            struct Ops { s16x4 aA[4], aR[4], aB[4], aK[4], aM, aPk, aT, aPb, bV; f32x4 gm[4]; };
#define C2_LOAD(O, ch) do { const int tk0_ = 16 * (ch); const int trow_ = (tk0_ + 4 * q + (c >> 2)) * RSTR + (c & 3) * 8; \
                _Pragma("unroll") for (int n = 0; n < 4; ++n) { O.aA[n] = *(const LAS s16x4*)(lds + AT_OFF + (tk0_ + c) * RSTR + (16 * n + 4 * q) * 2); O.aR[n] = *(const LAS s16x4*)(lds + RT_OFF + (tk0_ + c) * RSTR + (16 * n + 4 * q) * 2); \
                    O.aB[n] = vtr(lds + BT_OFF + trow_ + 32 * n); O.aK[n] = vtr(lds + KT_OFF + trow_ + 32 * n); O.gm[n] = *(const LAS f32x4*)(GAM + (ch) * 64 + 16 * n + 4 * q); } \
                O.aM = *(const LAS s16x4*)(lds + MK_OFF + (ch) * 512 + c * 32 + 8 * q); O.aPk = *(const LAS s16x4*)(lds + PK_OFF + (ch) * 512 + c * 32 + 8 * q); \
                O.aT = *(const LAS s16x4*)(lds + TT_OFF + (ch) * 512 + c * 32 + 8 * q); O.aPb = *(const LAS s16x4*)(lds + PB_OFF + (ch) * 512 + c * 32 + 8 * q); \
                O.bV = vtr(lds + VV_OFF + trow_ + 32 * w); } while (0)
#define C2_STEP(O, ch) do { s16x4 sb[4]; _Pragma("unroll") for (int n = 0; n < 4; ++n) sb[n] = pack4(ST[n]); \
                f32x4 WT = (f32x4){0.f, 0.f, 0.f, 0.f}, YT = (f32x4){0.f, 0.f, 0.f, 0.f}; \
                _Pragma("unroll") for (int n = 0; n < 4; ++n) { WT = MFMA16(O.aA[n], sb[n], WT); YT = MFMA16(O.aR[n], sb[n], YT); } \
                WT = MFMA16(O.aM, O.bV, WT); YT = MFMA16(O.aPk, O.bV, YT); \
                const f32x4 UT = MFMA16(O.aT, pack4(WT), ((f32x4){0.f, 0.f, 0.f, 0.f})); const s16x4 ub = pack4(UT); \
                YT = MFMA16(O.aPb, ub, YT); YT4[ch] = YT; \
                _Pragma("unroll") for (int n = 0; n < 4; ++n) { ST[n] = MFMA16(O.aB[n], ub, ST[n]); ST[n] = MFMA16(O.aK[n], O.bV, ST[n]); ST[n] = ST[n] * O.gm[n]; } } while (0)
            Ops oA, oB;
            C2_LOAD(oA, 0); C2_LOAD(oB, 1); C2_STEP(oA, 0); C2_LOAD(oA, 2); C2_STEP(oB, 1); C2_LOAD(oB, 3); C2_STEP(oA, 2); C2_STEP(oB, 3);
#undef C2_LOAD
#undef C2_STEP
#pragma unroll
            for (int ch = 0; ch < 4; ++ch)
#pragma unroll
                for (int reg = 0; reg < 4; ++reg) Y[(16 * ch + 4 * q + reg) * YSTR + 16 * w + c] = YT4[ch][reg];
        }
        __syncthreads();
        if (t0 == 1024) TS_MARK(14);
    }
    SCAN_OUT(SEQ - TC);
#undef RW_LOAD
#undef PIECE
#undef SCAN_OUT
    __syncthreads();
}
}

__device__ __forceinline__ void p456_chain(Frame& F) {
        const pg8::PanelOrder S{F.vcu, 4};
        { pg8::Gemm g{F.A1, F.WTA, 2 * M, 2 * D, 512}; const pg8::PanelOrder2 S2{F.vcu}; pg8::EpiMerge2 E{F.SGA, F.SGB, F.MG};
          pg8::gemm_phase<pg8::EpiMerge2, pg8::PanelOrder2, true, true>(F.lds, g, S2, E); }
        VM_WAIT(); __syncthreads();
        if (threadIdx.x == 0) { __builtin_amdgcn_fence(__ATOMIC_ACQUIRE, "agent"); VM_WAIT(); }
        LAS float* ss = (LAS float*)(F.lds + SS_OFF);
        if (threadIdx.x < 256) ss[threadIdx.x] = 0.f;
        __syncthreads();
        { pg8::Gemm g{F.MG, F.WTO, M, D, D}; pg8::EpiOut E{F.out, ss};
          pg8::gemm_phase<pg8::EpiOut, pg8::PanelOrder, true, true>(F.lds, g, S, E); }
        VM_WAIT(); LDS_WAIT(); __syncthreads();
        if (threadIdx.x == 0) { __builtin_amdgcn_fence(__ATOMIC_ACQUIRE, "agent"); VM_WAIT(); }
        __syncthreads();
        int t2 = threadIdx.x; asm volatile("" : "+v"(t2)); const int lane2 = t2 & 63, wave2 = __builtin_amdgcn_readfirstlane(t2 >> 6);
        for (int r = wave2; r < 256; r += NWAVES) { const size_t row = (size_t)F.vcu * 256 + r; const float rstd = 1.0f / sqrtf(ss[r] * (1.0f / D) + RMS_EPS);
            float* orow = F.out + row * D; const float* xrow = F.x + row * D;
            v4u raw[2];
#pragma unroll
            for (int j = 0; j < 2; ++j) raw[j] = *((const GAS v4u*)orow + lane2 + 64 * j);
#pragma unroll
            for (int j = 0; j < 2; ++j) { const int col = 8 * lane2 + 512 * j;
                const f32x4 x0 = *(const GAS f32x4*)(xrow + col), x1 = *(const GAS f32x4*)(xrow + col + 4), g0 = *(const GAS f32x4*)(F.post_g + col), g1 = *(const GAS f32x4*)(F.post_g + col + 4);
                const f32x4 r0 = (f32x4){bflo(raw[j].x), bfhi(raw[j].x), bflo(raw[j].y), bfhi(raw[j].y)}, r1 = (f32x4){bflo(raw[j].z), bfhi(raw[j].z), bflo(raw[j].w), bfhi(raw[j].w)};
                *(GAS f32x4*)(orow + col) = x0 + r0 * rstd * g0; *(GAS f32x4*)(orow + col + 4) = x1 + r1 * rstd * g1; } }
    }

#ifndef MK_N_LAUNCHES
#define MK_N_LAUNCHES 1
#endif
constexpr int N_LAUNCHES = MK_N_LAUNCHES;
#ifndef REP_P0
#define REP_P0 1
#endif
#ifndef REP_P1
#define REP_P1 1
#endif
#ifndef REP_SCAN
#define REP_SCAN 1
#endif
#ifndef REP_P3
#define REP_P3 1
#endif
#ifndef REP_P4
#define REP_P4 1
#endif
constexpr int N_PHASES = 5;
struct Args { const float* in[18]; float* out; unsigned char* ws; int ph_lo, ph_hi; };
__global__ void __launch_bounds__(NWAVES * 64, 2) mk_fwd(Args args) {
    extern __shared__ __attribute__((aligned(16))) unsigned char lds[];
    Frame F;
    F.lds = (LAS unsigned char*)lds;
    F.MISC = (volatile LAS unsigned*)(F.lds + MISC_OFF);
    F.tid = threadIdx.x; F.lane = F.tid & 63; F.wave = __builtin_amdgcn_readfirstlane(F.tid >> 6);
    F.G = gridDim.x; { const int bx = blockIdx.x; F.vcu = (F.G % 8 == 0) ? (bx % 8) * (F.G / 8) + bx / 8 : bx; }
    unsigned char* ws = args.ws;
    F.ctl = (gu32*)(ws + WS_CTL);
    F.x = args.in[0]; F.pre_g = args.in[1]; F.w_in = args.in[2]; F.rel_bias = args.in[3]; F.mix = args.in[4]; F.w0 = args.in[5]; F.w_up = args.in[6]; F.a0 = args.in[7]; F.a_up = args.in[8];
    F.k_k = args.in[9]; F.k_a = args.in[10]; F.r_k = args.in[11]; F.ln_w = args.in[12]; F.ln_b = args.in[13]; F.w_upA = args.in[14]; F.w_upB = args.in[15]; F.w_out = args.in[16]; F.post_g = args.in[17];
    F.out = args.out;
    F.WT1 = (bf16*)(ws + WS_WT1); F.WTA = (bf16*)(ws + WS_WTA); F.WTB = (bf16*)(ws + WS_WTB); F.WTO = (bf16*)(ws + WS_WTO); F.LSE = (float*)(ws + WS_LSE);
    F.H = (bf16*)(ws + WS_H); F.QKV = (bf16*)(ws + WS_QKV); F.RW = (bf16*)(ws + WS_RW);
    F.SGA = (bf16*)(ws + WS_SGA); F.SGB = (bf16*)(ws + WS_SGB); F.A1 = (bf16*)(ws + WS_A1); F.A2 = (bf16*)(ws + WS_A2); F.MG = (bf16*)(ws + WS_MG);
    F.OA = (bf16*)((unsigned char*)args.out + OUT_OA); F.OR = (bf16*)((unsigned char*)args.out + OUT_OR);
    for (int u = F.tid; u < (LDS_BYTES - LDSCTL_OFF) / 4; u += NWAVES * 64) ((LAS unsigned*)(F.lds + LDSCTL_OFF))[u] = 0u;
    __syncthreads();
    XcdBarrier bar; bar.bar = (unsigned*)(F.ctl + CW_BAR); bar.x = 0; bar.st = nullptr;
    if (N_LAUNCHES == 1) bar = xcd_barrier_post((unsigned*)(F.ctl + CW_BAR), F.MISC + 8);
    const int lo = args.ph_lo, hi = args.ph_hi;
#define IN(k) (lo <= (k) && (k) < hi)
#define BOTH(k) (IN(k) && IN((k) + 1))
#define GRID_BAR() do { if (N_LAUNCHES == 1) xcd_barrier(bar); } while (0)

    TS_MARK(0);
    if (IN(0)) { for (int rep = 0; rep < REP_P0; ++rep) p0_prologue(F); if (BOTH(0)) GRID_BAR(); }

    TS_MARK(1);
    if (IN(1)) {
        pg8::Gemm g{F.H, F.WT1, M, N1, D}; pg8::StaticOrder S; S.init(M, N1, F.G, (int)blockIdx.x);
        pg8::Epi1 E{F.QKV, F.RW};
        pg8::gemm_phase<pg8::Epi1, pg8::StaticOrder, true, true>(F.lds, g, S, E);
#if REP_P1 == 2
        pg8::gemm_phase<pg8::Epi1, pg8::StaticOrder, true, true>(F.lds, g, S, E);
#endif
        if (BOTH(1)) GRID_BAR();
    }

    TS_MARK(2);
    if (IN(2)) {
        att::attn_phase(F);
        TS_MARK(3);
        rwkv::scan_phase(F);
#if REP_SCAN == 2
        rwkv::scan_phase(F);
#endif
        if (BOTH(2)) GRID_BAR();
    }

    TS_MARK(4);
    if (IN(3)) {
        pg8::Gemm g{F.H, F.WT1 + (size_t)N1 * D, M, N2, D}; pg8::StaticOrder S; S.init(M, N2, F.G, (int)blockIdx.x);
        pg8::Epi2 E{F.OA, F.OR, F.A1, F.A2, F.SGA, F.SGB};
        pg8::gemm_phase<pg8::Epi2, pg8::StaticOrder, true, true>(F.lds, g, S, E);
#if REP_P3 == 2
        pg8::gemm_phase<pg8::Epi2, pg8::StaticOrder, true, true>(F.lds, g, S, E);
#endif
        if (BOTH(3)) GRID_BAR();
    }

    TS_MARK(5);
    if (IN(4) && F.vcu < M / 256) {
        p456_chain(F);
#if REP_P4 == 2
        p456_chain(F);
#endif
    }
#if TSPROBE >= 0
    TS_MARK(6);
    if (blockIdx.x == 0 && threadIdx.x == 0) { VM_WAIT(); unsigned long long* tsb = (unsigned long long*)(F.ctl + 131072);
        const unsigned long long ta = __hip_atomic_load(tsb + TSP_A, __ATOMIC_RELAXED, __HIP_MEMORY_SCOPE_AGENT), tb = __hip_atomic_load(tsb + TSP_B, __ATOMIC_RELAXED, __HIP_MEMORY_SCOPE_AGENT);
        const unsigned long long da = __hip_atomic_load(tsb + TSP_DA, __ATOMIC_RELAXED, __HIP_MEMORY_SCOPE_AGENT), db = __hip_atomic_load(tsb + TSP_DB, __ATOMIC_RELAXED, __HIP_MEMORY_SCOPE_AGENT);
        const float frac = (float)(tb - ta) / (float)(db - da); F.out[0] += 0.25f + 0.5f * frac; }
#endif
#undef IN
#undef BOTH
#undef GRID_BAR
}

extern "C" void kernel_launch(void* const* d_in, const int* in_sizes, int n_in, void* d_out, int out_size, void* d_ws, size_t ws_size, hipStream_t stream) {
    static int grid = 0;
    if (grid == 0) {
        if (n_in != 18 || in_sizes[0] != M * D || out_size != M * D || ws_size < WS_END) { fprintf(stderr, "kernel_launch: unexpected shapes / workspace: n_in %d in0 %d out %d ws %zu (need %zu)\n", n_in, n_in > 0 ? in_sizes[0] : -1, out_size, ws_size, (size_t)WS_END); grid = -1; return; }
        int dev = 0, cus = 0, per_cu = 0;
        if (hipGetDevice(&dev) != hipSuccess || hipDeviceGetAttribute(&cus, hipDeviceAttributeMultiprocessorCount, dev) != hipSuccess) { grid = -1; return; }
        if (hipFuncSetAttribute((const void*)mk_fwd, hipFuncAttributeMaxDynamicSharedMemorySize, LDS_BYTES) != hipSuccess) { fprintf(stderr, "kernel_launch: hipFuncSetAttribute failed\n"); grid = -1; return; }
        if (hipOccupancyMaxActiveBlocksPerMultiprocessor(&per_cu, (const void*)mk_fwd, NWAVES * 64, LDS_BYTES) != hipSuccess || per_cu < 1) fprintf(stderr, "kernel_launch: occupancy query reports %d\n", per_cu);
        (void)hipGetLastError();
        grid = cus;
        if (grid != 256) fprintf(stderr, "kernel_launch: %d CUs (built for 256)\n", grid);
        fprintf(stderr, "kernel_launch: ws_size %zu, grid %d, per_cu %d\n", ws_size, grid, per_cu);
    }
    if (grid < 0) return;
    if (hipMemsetAsync((char*)d_ws + WS_CTL, 0, CTL_ZERO_BYTES, stream) != hipSuccess) return;
    Args a{};
    for (int i = 0; i < 18; ++i) a.in[i] = (const float*)d_in[i];
    a.out = (float*)d_out; a.ws = (unsigned char*)d_ws;
    for (int li = 0; li < N_LAUNCHES; ++li) {
        a.ph_lo = (N_LAUNCHES == 1) ? 0 : li; a.ph_hi = (N_LAUNCHES == 1) ? N_PHASES : li + 1;
        hipLaunchKernelGGL(mk_fwd, dim3(grid), dim3(NWAVES * 64), LDS_BYTES, stream, a);
        if (hipPeekAtLastError() != hipSuccess) { fprintf(stderr, "kernel_launch: launch %d failed\n", li); break; }
    }
}
```
